# Optimizing an MI355X kernel written in HIP

```python
import jax, jax.numpy as jnp
from jax import lax
import numpy as np

D_MODEL = 1024
BATCH = 4
SEQ = 4096
DEPTH = 1

HEAD_DIM = D_MODEL // 16
CONV_HEADS = 8
FFT_GROUPS = 8
CONV_CH = CONV_HEADS * HEAD_DIM
FFT_CH = FFT_GROUPS * HEAD_DIM
MIX_WIDTH = CONV_CH + FFT_CH
MIX_HEADS = CONV_HEADS + FFT_GROUPS
IN_COLS = 3 * CONV_CH + FFT_CH
CONV_K = 3
MEM_LEN = 256
XA_HEADS = 4
XA_HEAD_DIM = D_MODEL // XA_HEADS
N_GROUPS = 4
EXPERTS_PER_GROUP = 8
N_EXPERTS = N_GROUPS * EXPERTS_PER_GROUP
TOP_K = 2
D_EXPERT = D_MODEL // 2
ROUTE_BLOCK = 128
EPS = 1e-6

kernel_name = "hybrid_conv_fourier_xattn_hmoe_encoder"


def rmsnorm(x, g):
    xf = x.astype(jnp.float32)
    y = xf * lax.rsqrt(jnp.mean(xf * xf, axis=-1, keepdims=True) + EPS)
    return (y * g.astype(jnp.float32)).astype(x.dtype)


def parallel_mixer(h, w_in, conv_w, conv_b, head_norm_g, w_out):
    B, S, _ = h.shape
    u = h @ w_in
    b_gate, c_gate, v, u_f = jnp.split(u, [CONV_CH, 2 * CONV_CH, 3 * CONV_CH], axis=-1)
    z = lax.conv_general_dilated(
        c_gate * v, conv_w[:, None, :], window_strides=(1,),
        padding=[(CONV_K // 2, CONV_K // 2)],
        dimension_numbers=("NWC", "WIO", "NWC"),
        feature_group_count=CONV_CH) + conv_b
    y_conv = (b_gate * z).reshape(B, S, CONV_HEADS, HEAD_DIM)
    uf = u_f.reshape(B, S, FFT_GROUPS, HEAD_DIM).astype(jnp.float32)
    y_fft = jnp.fft.fftn(uf, axes=(1, 3), norm="ortho").real.astype(h.dtype)
    heads = jnp.concatenate([y_conv, y_fft], axis=2)
    heads = rmsnorm(heads, head_norm_g)
    return heads.reshape(B, S, MIX_WIDTH) @ w_out


def memory_cross_attention(h, m, w_q, w_kv, w_o):
    B, S, _ = h.shape
    q = (h @ w_q).reshape(B, S, XA_HEADS, XA_HEAD_DIM)
    k, v = jnp.split(m @ w_kv, 2, axis=-1)
    k = k.reshape(B, -1, XA_HEADS, XA_HEAD_DIM)
    v = v.reshape(B, -1, XA_HEADS, XA_HEAD_DIM)
    s = jnp.einsum("bqhd,bkhd->bhqk", q, k).astype(jnp.float32) * (XA_HEAD_DIM ** -0.5)
    p = jax.nn.softmax(s, axis=-1).astype(v.dtype)
    o = jnp.einsum("bhqk,bkhd->bqhd", p, v).reshape(B, S, D_MODEL)
    return o @ w_o


def hierarchical_moe(h, w_rg, b_rg, w_re, b_re, w_gate, w_up, w_down):
    B, S, D = h.shape
    T = B * S
    hf = h.reshape(T, D)
    g_prob = jax.nn.softmax((hf @ w_rg).astype(jnp.float32) + b_rg.astype(jnp.float32), axis=-1)
    g_idx = jnp.argmax(g_prob, axis=-1).astype(jnp.int32)
    g_w = jnp.take_along_axis(g_prob, g_idx[:, None], axis=-1)
    e_logits = ((hf @ w_re).astype(jnp.float32) + b_re.astype(jnp.float32)).reshape(T, N_GROUPS, EXPERTS_PER_GROUP)
    e_logits = jnp.take_along_axis(e_logits, g_idx[:, None, None], axis=1)[:, 0]
    e_prob = jax.nn.softmax(e_logits, axis=-1)
    top_p, top_e = lax.top_k(e_prob, TOP_K)
    gate = (g_w * top_p / jnp.sum(top_p, axis=-1, keepdims=True)).reshape(-1)
    eid = (g_idx[:, None] * EXPERTS_PER_GROUP + top_e.astype(jnp.int32)).reshape(-1)
    tok = jnp.arange(T * TOP_K, dtype=jnp.int32) // TOP_K
    order = jnp.argsort(eid)
    se = eid[order]
    counts = jnp.bincount(eid, length=N_EXPERTS)
    starts = jnp.cumsum(counts) - counts
    padded = (counts + ROUTE_BLOCK - 1) // ROUTE_BLOCK * ROUTE_BLOCK
    pend = jnp.cumsum(padded)
    pstart = pend - padded
    dest = pstart[se] + jnp.arange(T * TOP_K, dtype=jnp.int32) - starts[se]
    n_blk = -(-(T * TOP_K + N_EXPERTS * ROUTE_BLOCK) // ROUTE_BLOCK)
    P = n_blk * ROUTE_BLOCK
    slot_tok = jnp.zeros((P,), jnp.int32).at[dest].set(tok[order])
    slot_w = jnp.zeros((P,), jnp.float32).at[dest].set(gate[order])
    blk_start = jnp.arange(n_blk, dtype=pend.dtype) * ROUTE_BLOCK
    blk_e = jnp.minimum(jnp.searchsorted(pend, blk_start, side="right"), N_EXPERTS - 1)
    xs = hf[slot_tok].reshape(n_blk, ROUTE_BLOCK, D)

    def expert_block(args):
        xb, e = args
        a = xb @ w_gate[e]
        b = xb @ w_up[e]
        return (jax.nn.silu(a) * b) @ w_down[e]

    ys = lax.map(expert_block, (xs, blk_e)).reshape(P, D)
    out = jnp.zeros((T, D), h.dtype).at[slot_tok].add(ys * slot_w[:, None].astype(ys.dtype))
    return out.reshape(B, S, D)


def setup_inputs(seed: int = 0) -> dict:
    key = jax.random.key(seed)
    ks = jax.random.split(key, 24)
    L, D = DEPTH, D_MODEL
    nrm = jax.random.normal
    f32 = jnp.float32

    def gain(k, shape):
        return jnp.ones(shape, f32) + 0.01 * nrm(k, shape, f32)

    return {
        "x": nrm(ks[0], (BATCH, SEQ, D), f32),
        "mem": nrm(ks[1], (BATCH, MEM_LEN, D), f32),
        "norm_mix_g": gain(ks[2], (L, D)),
        "w_in": nrm(ks[3], (L, D, IN_COLS), f32) * D ** -0.5,
        "conv_w": nrm(ks[4], (L, CONV_K, CONV_CH), f32) * CONV_K ** -0.5,
        "conv_b": 0.01 * nrm(ks[5], (L, CONV_CH), f32),
        "head_norm_g": gain(ks[6], (L, MIX_HEADS, HEAD_DIM)),
        "w_out": nrm(ks[7], (L, MIX_WIDTH, D), f32) * MIX_WIDTH ** -0.5,
        "norm_xa_g": gain(ks[8], (L, D)),
        "norm_mem_g": gain(ks[9], (L, D)),
        "w_q": nrm(ks[10], (L, D, D), f32) * D ** -0.5,
        "w_kv": nrm(ks[11], (L, D, 2 * D), f32) * D ** -0.5,
        "w_o": nrm(ks[12], (L, D, D), f32) * D ** -0.5,
        "norm_ffn_g": gain(ks[13], (L, D)),
        "w_route_group": nrm(ks[14], (L, D, N_GROUPS), f32) * D ** -0.5,
        "b_route_group": 0.01 * nrm(ks[15], (L, N_GROUPS), f32),
        "w_route_expert": nrm(ks[16], (L, D, N_EXPERTS), f32) * D ** -0.5,
        "b_route_expert": 0.01 * nrm(ks[17], (L, N_EXPERTS), f32),
        "w_gate": nrm(ks[18], (L, N_EXPERTS, D, D_EXPERT), f32) * D ** -0.5,
        "w_up": nrm(ks[19], (L, N_EXPERTS, D, D_EXPERT), f32) * D ** -0.5,
        "w_down": nrm(ks[20], (L, N_EXPERTS, D_EXPERT, D), f32) * D_EXPERT ** -0.5,
        "final_norm_g": gain(ks[21], (D,)),
    }


def reference(x, mem, norm_mix_g, w_in, conv_w, conv_b, head_norm_g, w_out,
              norm_xa_g, norm_mem_g, w_q, w_kv, w_o,
              norm_ffn_g, w_route_group, b_route_group, w_route_expert, b_route_expert,
              w_gate, w_up, w_down, final_norm_g):
    for l in range(DEPTH):
        x = x + parallel_mixer(rmsnorm(x, norm_mix_g[l]), w_in[l], conv_w[l], conv_b[l],
                               head_norm_g[l], w_out[l])
        x = x + memory_cross_attention(rmsnorm(x, norm_xa_g[l]), rmsnorm(mem, norm_mem_g[l]),
                                       w_q[l], w_kv[l], w_o[l])
        x = x + hierarchical_moe(rmsnorm(x, norm_ffn_g[l]), w_route_group[l], b_route_group[l],
                                 w_route_expert[l], b_route_expert[l],
                                 w_gate[l], w_up[l], w_down[l])
    return rmsnorm(x, final_norm_g)
```

```cpp
#include <hip/hip_runtime.h>
#include <cstdint>
#include <cstdio>

constexpr int T = 16384, D = 1024, SEQ = 4096, NB = 4, MEMLEN = 256;
constexpr int INCOLS = 2048, CONVCH = 512;
constexpr int NEXP = 32, DEXP = 512;
constexpr float EPS = 1e-6f;
constexpr size_t MiB = 1u << 20;

constexpr size_t WS_SMALL = 0;
constexpr size_t WS_X = 16 * MiB;
constexpr size_t WS_A = 80 * MiB;
constexpr size_t WS_B = 144 * MiB;
constexpr size_t SM_MN = 0;
constexpr size_t SM_KV = 4 * MiB;
constexpr size_t SM_LIST = 12 * MiB;
constexpr size_t SM_CNT = 14 * MiB;
constexpr size_t SM_TAB = 14 * MiB + 4096;
constexpr size_t SM_TOKE = 14 * MiB + 65536;
constexpr size_t SM_STOK = 15 * MiB;

struct NG {
    const float* A; const float* B; float* C; const float* R;
    const int* gather; const int* mcount; const int* cbase; const int* sidx; const float* sw; const float* tab;
    long sA, sB, sC; int gz; int abase;
    int lda, ldb, ldc, ldr; int M, N, K; int amode;
};

__global__ void __launch_bounds__(256) naive_gemm(NG g) {
    const int z = blockIdx.z;
    const float* A = g.A + (long)z * g.sA; const float* B = g.B + (long)z * g.sB;
    const int M = g.mcount ? g.mcount[z] : g.M;
    const int m0 = blockIdx.y * 64, n0 = blockIdx.x * 64; if (m0 >= M) return;
    const int rowbase = g.cbase ? g.cbase[z] : 0;
    float* C = g.C + (long)z * g.sC;
    __shared__ float As[16][65]; __shared__ float Bs[16][64];
    const int tid = threadIdx.x, tx = tid & 15, ty = tid >> 4;
    float acc[4][4] = {};
    for (int k0 = 0; k0 < g.K; k0 += 16) {
#pragma unroll
        for (int i = 0; i < 4; ++i) { const int idx = tid + i * 256, r = idx >> 4, kk = idx & 15; const int row = m0 + r; float v = 0.f;
            if (row < M) {
                if (g.amode == 1) { const int k = k0 + kk, s = k & 4095; const int ix = (row * s) & 4095; v = g.tab[(k < 4096 ? 0 : 4096) + ix]; }
                else { const int arow = g.gather ? (g.gather[(long)z * g.gz + row] >> 1) : (g.abase ? rowbase + row : row); v = A[(long)arow * g.lda + k0 + kk]; } }
            As[kk][r] = v; }
#pragma unroll
        for (int i = 0; i < 4; ++i) { const int idx = tid + i * 256, kk = idx >> 6, c = idx & 63; Bs[kk][c] = B[(long)(k0 + kk) * g.ldb + n0 + c]; }
        __syncthreads();
#pragma unroll
        for (int kk = 0; kk < 16; ++kk) { float a[4], b[4];
#pragma unroll
            for (int i = 0; i < 4; ++i) { a[i] = As[kk][ty * 4 + i]; b[i] = Bs[kk][tx * 4 + i]; }
#pragma unroll
            for (int i = 0; i < 4; ++i)
#pragma unroll
                for (int j = 0; j < 4; ++j) acc[i][j] += a[i] * b[j]; }
        __syncthreads();
    }
#pragma unroll
    for (int i = 0; i < 4; ++i) { const int row = m0 + ty * 4 + i; if (row >= M) continue;
#pragma unroll
        for (int j = 0; j < 4; ++j) { const int col = n0 + tx * 4 + j; float v = acc[i][j];
            if (g.sidx) { const int slot = rowbase + row; atomicAdd(&g.C[(long)g.sidx[slot] * g.ldc + col], g.sw[slot] * v); }
            else { if (g.R) v += g.R[(long)(rowbase + row) * g.ldr + col]; C[(long)(rowbase + row) * g.ldc + col] = v; } } }
}

__device__ __forceinline__ float wave_sum(float v) {
#pragma unroll
    for (int o = 1; o < 64; o <<= 1) v += __shfl_xor(v, o);
    return v;
}
__device__ __forceinline__ float wave_max(float v) {
#pragma unroll
    for (int o = 1; o < 64; o <<= 1) v = fmaxf(v, __shfl_xor(v, o));
    return v;
}

__global__ void __launch_bounds__(256) rmsnorm_rows(const float* x, const float* g, float* y, int rows) {
    const int row = blockIdx.x * 4 + (threadIdx.x >> 6), lane = threadIdx.x & 63; if (row >= rows) return;
    const float* xr = x + (long)row * D; float v[16]; float s = 0.f;
#pragma unroll
    for (int j = 0; j < 16; ++j) { v[j] = xr[lane + 64 * j]; s += v[j] * v[j]; }
    const float r = rsqrtf(wave_sum(s) * (1.f / D) + EPS);
#pragma unroll
    for (int j = 0; j < 16; ++j) y[(long)row * D + lane + 64 * j] = v[j] * r * g[lane + 64 * j];
}

__global__ void make_tab(float* tab) {
    const int i = blockIdx.x * blockDim.x + threadIdx.x; if (i >= 4096) return;
    tab[i] = cospif((float)i / 2048.f); tab[4096 + i] = sinpif((float)i / 2048.f);
}

__global__ void __launch_bounds__(256) chan_dft(const float* u, float* V) {
    const int t = blockIdx.x, tid = threadIdx.x;
    __shared__ float uf[512];
    uf[tid] = u[(long)t * INCOLS + 1536 + tid]; uf[tid + 256] = u[(long)t * INCOLS + 1536 + 256 + tid];
    __syncthreads();
    const int b = t / SEQ, s = t % SEQ;
    for (int o = tid; o < 512; o += 256) { const int gidx = o >> 6, cp = o & 63; float sr = 0.f, si = 0.f;
        for (int c = 0; c < 64; ++c) { const int ix = (c * cp) & 63; const float ang = (float)ix / 32.f; const float x = uf[gidx * 64 + c]; sr += x * cospif(ang); si -= x * sinpif(ang); }
        V[((long)(b * 2 + 0) * SEQ + s) * 512 + o] = sr * (1.f / 512.f);
        V[((long)(b * 2 + 1) * SEQ + s) * 512 + o] = si * (1.f / 512.f); }
}

__global__ void __launch_bounds__(256) heads_kernel(const float* u, const float* Y, const float* conv_w, const float* conv_b, const float* hg, float* heads) {
    const int wid = blockIdx.x * 4 + (threadIdx.x >> 6), lane = threadIdx.x & 63;
    const int t = wid >> 4, head = wid & 15; if (t >= T) return;
    float y;
    if (head < 8) { const int c = head * 64 + lane; const int s = t % SEQ;
        const float* ut = u + (long)t * INCOLS;
        float z = conv_b[c];
        z += ut[512 + c] * ut[1024 + c] * conv_w[1 * CONVCH + c];
        if (s > 0) z += ut[-INCOLS + 512 + c] * ut[-INCOLS + 1024 + c] * conv_w[0 * CONVCH + c];
        if (s < SEQ - 1) z += ut[INCOLS + 512 + c] * ut[INCOLS + 1024 + c] * conv_w[2 * CONVCH + c];
        y = ut[c] * z;
    } else y = Y[(long)t * 512 + (head - 8) * 64 + lane];
    const float r = rsqrtf(wave_sum(y * y) * (1.f / 64.f) + EPS);
    heads[(long)t * D + head * 64 + lane] = y * r * hg[head * 64 + lane];
}

__global__ void __launch_bounds__(256) attn_naive(const float* q, const float* kv, float* o) {
    __shared__ float ps[4][256]; __shared__ float qs[4][256];
    const int w = threadIdx.x >> 6, lane = threadIdx.x & 63;
    const int wid = blockIdx.x * 4 + w; const int t = wid >> 2, h = wid & 3; const int b = t / SEQ;
    for (int j = 0; j < 4; ++j) qs[w][lane + 64 * j] = q[(long)t * D + h * 256 + lane + 64 * j];
    __syncthreads();
    float sc[4];
    for (int j = 0; j < 4; ++j) { const int key = lane + 64 * j; const float* kr = kv + (long)(b * MEMLEN + key) * 2048 + h * 256; float s = 0.f;
        for (int d = 0; d < 256; ++d) s += qs[w][d] * kr[d];
        sc[j] = s * 0.0625f; }
    float m = fmaxf(fmaxf(sc[0], sc[1]), fmaxf(sc[2], sc[3])); m = wave_max(m);
    float l = 0.f;
    for (int j = 0; j < 4; ++j) { sc[j] = __expf(sc[j] - m); l += sc[j]; }
    l = wave_sum(l);
    for (int j = 0; j < 4; ++j) ps[w][lane + 64 * j] = sc[j] / l;
    __syncthreads();
    for (int j = 0; j < 4; ++j) { const int d = lane + 64 * j; float acc = 0.f;
        for (int key = 0; key < 256; ++key) acc += ps[w][key] * kv[(long)(b * MEMLEN + key) * 2048 + 1024 + h * 256 + d];
        o[(long)t * D + h * 256 + d] = acc; }
}

__global__ void __launch_bounds__(256) router_kernel(const float* hf, const float* wrg, const float* brg, const float* wre, const float* bre,
                                                      int* tok_e, float* tok_g, int* cnt, int* list) {
    const int t = blockIdx.x * 4 + (threadIdx.x >> 6), lane = threadIdx.x & 63; if (t >= T) return;
    float lg[36];
#pragma unroll
    for (int j = 0; j < 36; ++j) lg[j] = 0.f;
    for (int i = 0; i < 16; ++i) { const int k = lane + 64 * i; const float x = hf[(long)t * D + k];
#pragma unroll
        for (int j = 0; j < 4; ++j) lg[j] += x * wrg[k * 4 + j];
#pragma unroll
        for (int j = 0; j < 32; ++j) lg[4 + j] += x * wre[k * 32 + j]; }
    __shared__ float sl[4][48];
    const int w = threadIdx.x >> 6;
#pragma unroll
    for (int j = 0; j < 36; ++j) { const float v = wave_sum(lg[j]); if (lane == 0) sl[w][j] = v; }
    __builtin_amdgcn_s_waitcnt(0); __builtin_amdgcn_wave_barrier();
    if (lane == 0) {
        float gm = -1e30f; int gi = 0;
        for (int j = 0; j < 4; ++j) { const float v = sl[w][j] + brg[j]; if (v > gm) { gm = v; gi = j; } }
        float gs = 0.f; for (int j = 0; j < 4; ++j) gs += __expf(sl[w][j] + brg[j] - gm);
        const float gw = 1.f / gs;
        float em = -1e30f;
        for (int j = 0; j < 8; ++j) { const float v = sl[w][4 + gi * 8 + j] + bre[gi * 8 + j]; sl[w][36 + j] = v; em = fmaxf(em, v); }
        float es = 0.f; for (int j = 0; j < 8; ++j) { const float p = __expf(sl[w][36 + j] - em); sl[w][36 + j] = p; es += p; }
        int i0 = 0; float p0 = sl[w][36];
        for (int j = 1; j < 8; ++j) { const float p = sl[w][36 + j]; if (p > p0) { p0 = p; i0 = j; } }
        int i1 = -1; float p1 = -1.f;
        for (int j = 0; j < 8; ++j) { const float p = sl[w][36 + j]; if (j != i0 && p > p1) { p1 = p; i1 = j; } }
        p0 /= es; p1 /= es;
        const float ssum = p0 + p1;
        const int e0 = gi * 8 + i0, e1 = gi * 8 + i1;
        tok_e[t * 2 + 0] = e0; tok_e[t * 2 + 1] = e1;
        tok_g[t * 2 + 0] = gw * p0 / ssum; tok_g[t * 2 + 1] = gw * p1 / ssum;
        const int q0 = atomicAdd(&cnt[e0], 1); list[e0 * T + q0] = t * 2 + 0;
        const int q1 = atomicAdd(&cnt[e1], 1); list[e1 * T + q1] = t * 2 + 1;
    }
}
__global__ void prefix_kernel(const int* cnt, int* base) { if (threadIdx.x == 0) { int s = 0; for (int e = 0; e < NEXP; ++e) { base[e] = s; s += cnt[e]; } base[NEXP] = s; } }
__global__ void slots_kernel(const int* cnt, const int* base, const int* list, const float* tok_g, int* stok, float* sgate) {
    const int e = blockIdx.y; const int p = blockIdx.x * blockDim.x + threadIdx.x; if (p >= cnt[e]) return;
    const int ent = list[e * T + p]; stok[base[e] + p] = ent >> 1; sgate[base[e] + p] = tok_g[ent];
}
__global__ void silu_mul(float* a, const float* b, long n) { const long i = (long)blockIdx.x * blockDim.x + threadIdx.x; if (i < n) { const float x = a[i]; a[i] = x / (1.f + __expf(-x)) * b[i]; } }
__global__ void __launch_bounds__(256) final_kernel(const float* x2, const float* mo, const float* g, float* out) {
    const int row = blockIdx.x * 4 + (threadIdx.x >> 6), lane = threadIdx.x & 63;
    float v[16]; float s = 0.f;
#pragma unroll
    for (int j = 0; j < 16; ++j) { const long ix = (long)row * D + lane + 64 * j; v[j] = x2[ix] + mo[ix]; s += v[j] * v[j]; }
    const float r = rsqrtf(wave_sum(s) * (1.f / D) + EPS);
#pragma unroll
    for (int j = 0; j < 16; ++j) out[(long)row * D + lane + 64 * j] = v[j] * r * g[lane + 64 * j];
}

static void gemm(hipStream_t st, NG g, int zs = 1, int maxM = -1) {
    const int M = maxM > 0 ? maxM : g.M;
    dim3 grid(g.N / 64, (M + 63) / 64, zs);
    hipLaunchKernelGGL(naive_gemm, grid, dim3(256), 0, st, g);
}

extern "C" void kernel_launch(void* const* d_in, const int* in_sizes, int n_in, void* d_out, int out_size, void* d_ws, size_t ws_size, hipStream_t stream) {
    const float* x = (const float*)d_in[0]; const float* mem = (const float*)d_in[1]; const float* norm_mix_g = (const float*)d_in[2];
    const float* w_in = (const float*)d_in[3]; const float* conv_w = (const float*)d_in[4]; const float* conv_b = (const float*)d_in[5];
    const float* head_norm_g = (const float*)d_in[6]; const float* w_out = (const float*)d_in[7]; const float* norm_xa_g = (const float*)d_in[8];
    const float* norm_mem_g = (const float*)d_in[9]; const float* w_q = (const float*)d_in[10]; const float* w_kv = (const float*)d_in[11];
    const float* w_o = (const float*)d_in[12]; const float* norm_ffn_g = (const float*)d_in[13]; const float* w_rg = (const float*)d_in[14];
    const float* b_rg = (const float*)d_in[15]; const float* w_re = (const float*)d_in[16]; const float* b_re = (const float*)d_in[17];
    const float* w_gate = (const float*)d_in[18]; const float* w_up = (const float*)d_in[19]; const float* w_down = (const float*)d_in[20];
    const float* final_g = (const float*)d_in[21];
    float* out = (float*)d_out; char* ws = (char*)d_ws;
    float* X = (float*)(ws + WS_X); float* A = (float*)(ws + WS_A); float* Bf = (float*)(ws + WS_B);
    float* mn = (float*)(ws + WS_SMALL + SM_MN); float* kv = (float*)(ws + WS_SMALL + SM_KV);
    int* list = (int*)(ws + WS_SMALL + SM_LIST); int* cnt = (int*)(ws + WS_SMALL + SM_CNT); int* base = cnt + 64;
    float* tab = (float*)(ws + WS_SMALL + SM_TAB); int* tok_e = (int*)(ws + WS_SMALL + SM_TOKE); float* tok_g = (float*)(tok_e + 2 * T);
    int* stok = (int*)(ws + WS_SMALL + SM_STOK); float* sgate = (float*)(stok + 2 * T);

    hipMemsetAsync(cnt, 0, 1024, stream);
    hipLaunchKernelGGL(make_tab, dim3(16), dim3(256), 0, stream, tab);
    hipLaunchKernelGGL(rmsnorm_rows, dim3(T / 4), dim3(256), 0, stream, x, norm_mix_g, A, T);
    { NG g{}; g.A = A; g.lda = D; g.B = w_in; g.ldb = INCOLS; g.C = Bf; g.ldc = INCOLS; g.M = T; g.N = INCOLS; g.K = D; gemm(stream, g); }
    hipLaunchKernelGGL(chan_dft, dim3(T), dim3(256), 0, stream, Bf, A);
    { NG g{}; g.amode = 1; g.tab = tab; g.A = nullptr; g.B = A; g.sB = 2L * SEQ * 512; g.ldb = 512; g.C = X; g.sC = (long)SEQ * 512; g.ldc = 512; g.M = SEQ; g.N = 512; g.K = 8192; gemm(stream, g, NB); }
    hipLaunchKernelGGL(heads_kernel, dim3(T * 16 / 4), dim3(256), 0, stream, Bf, X, conv_w, conv_b, head_norm_g, A);
    { NG g{}; g.A = A; g.lda = D; g.B = w_out; g.ldb = D; g.C = X; g.ldc = D; g.R = x; g.ldr = D; g.M = T; g.N = D; g.K = D; gemm(stream, g); }
    hipLaunchKernelGGL(rmsnorm_rows, dim3(T / 4), dim3(256), 0, stream, X, norm_xa_g, A, T);
    hipLaunchKernelGGL(rmsnorm_rows, dim3(NB * MEMLEN / 4), dim3(256), 0, stream, mem, norm_mem_g, mn, NB * MEMLEN);
    { NG g{}; g.A = A; g.lda = D; g.B = w_q; g.ldb = D; g.C = Bf; g.ldc = D; g.M = T; g.N = D; g.K = D; gemm(stream, g); }
    { NG g{}; g.A = mn; g.lda = D; g.B = w_kv; g.ldb = 2048; g.C = kv; g.ldc = 2048; g.M = NB * MEMLEN; g.N = 2048; g.K = D; gemm(stream, g); }
    float* o = Bf + (long)T * D;
    hipLaunchKernelGGL(attn_naive, dim3(T * 4 / 4), dim3(256), 0, stream, Bf, kv, o);
    { NG g{}; g.A = o; g.lda = D; g.B = w_o; g.ldb = D; g.C = X; g.ldc = D; g.R = X; g.ldr = D; g.M = T; g.N = D; g.K = D; gemm(stream, g); }
    hipLaunchKernelGGL(rmsnorm_rows, dim3(T / 4), dim3(256), 0, stream, X, norm_ffn_g, A, T);
    hipLaunchKernelGGL(router_kernel, dim3(T / 4), dim3(256), 0, stream, A, w_rg, b_rg, w_re, b_re, tok_e, tok_g, cnt, list);
    hipLaunchKernelGGL(prefix_kernel, dim3(1), dim3(64), 0, stream, cnt, base);
    hipLaunchKernelGGL(slots_kernel, dim3(T / 256, NEXP), dim3(256), 0, stream, cnt, base, list, tok_g, stok, sgate);
    float* ga = Bf; float* gb = Bf + (long)2 * T * DEXP;
    { NG g{}; g.A = A; g.lda = D; g.gather = list; g.gz = T; g.mcount = cnt; g.cbase = base; g.B = w_gate; g.sB = (long)D * DEXP; g.ldb = DEXP; g.C = ga; g.ldc = DEXP; g.M = T; g.N = DEXP; g.K = D; gemm(stream, g, NEXP, T); }
    { NG g{}; g.A = A; g.lda = D; g.gather = list; g.gz = T; g.mcount = cnt; g.cbase = base; g.B = w_up; g.sB = (long)D * DEXP; g.ldb = DEXP; g.C = gb; g.ldc = DEXP; g.M = T; g.N = DEXP; g.K = D; gemm(stream, g, NEXP, T); }
    hipLaunchKernelGGL(silu_mul, dim3((2L * T * DEXP + 255) / 256), dim3(256), 0, stream, ga, gb, 2L * T * DEXP);
    hipMemsetAsync(A, 0, (size_t)T * D * 4, stream);
    { NG g{}; g.A = ga; g.lda = DEXP; g.mcount = cnt; g.cbase = base; g.B = w_down; g.sB = (long)DEXP * D; g.ldb = D; g.C = A; g.ldc = D; g.sidx = stok; g.sw = sgate; g.M = T; g.N = D; g.K = DEXP; g.sA = 0; g.abase = 1; gemm(stream, g, NEXP, T); }
    hipLaunchKernelGGL(final_kernel, dim3(T / 4), dim3(256), 0, stream, X, A, final_g, out);
}
```

```cpp
#include <hip/hip_runtime.h>
#include <cstdint>
#include <cstdio>

#ifndef MK_SLOW
#define MK_SLOW 0
#endif

#define LAS __attribute__((address_space(3)))
#define GAS __attribute__((address_space(1)))
typedef unsigned short bf16_t;
typedef short bf16x8 __attribute__((ext_vector_type(8)));
typedef float f32x4 __attribute__((ext_vector_type(4)));
typedef float f32x2 __attribute__((ext_vector_type(2)));
typedef unsigned u32x4 __attribute__((ext_vector_type(4)));
typedef unsigned u32x2 __attribute__((ext_vector_type(2)));
typedef GAS unsigned gu32;

constexpr int T = 16384, D = 1024, SEQ = 4096, NB = 4, MEML = 256, NEXP = 32, DEXP = 512, INCOLS = 2048;
constexpr float EPS = 1e-6f;
constexpr float QSCALE = 0.0625f * 1.4426950408889634f;
constexpr int NWAVES = 8;

constexpr size_t MiB = 1u << 20;
constexpr size_t WS_CTL = 0, CTL_ZERO_BYTES = 1 * MiB;
constexpr size_t WS_WIN = 1 * MiB, WS_WOUT = 5 * MiB, WS_WQ = 7 * MiB, WS_WKV = 9 * MiB, WS_WO = 13 * MiB;
constexpr size_t WS_KB = 15 * MiB, WS_VT = 17 * MiB, WS_MB = 19 * MiB, WS_LIST = 21 * MiB, WS_MISC = 23 * MiB;
constexpr size_t MS_RSTD0 = 0, MS_RSTDM = 64 * 1024, MS_SSQ1 = 128 * 1024, MS_SSQ2 = 384 * 1024, MS_RSTD2 = 640 * 1024, MS_TOKG = 704 * 1024, MS_WR = 832 * 1024;
constexpr size_t WS_X1 = 24 * MiB;
constexpr size_t WS_UF = 24 * MiB, WS_YPART = 24 * MiB;
constexpr size_t WS_ACT0 = 88 * MiB, WS_ACT1 = 120 * MiB;
constexpr size_t WS_DFTM = 152 * MiB, WS_VTT = 216 * MiB, WS_WGU = 152 * MiB, WS_WD = 216 * MiB;
constexpr size_t WS_BG = 248 * MiB, WS_CV = 264 * MiB, WS_Y1 = 248 * MiB, WS_END = 280 * MiB;
constexpr int CW_BAR = 4096, CW_CNT = 16384;

constexpr int RING_BYTES = 131072, LDSCTL_OFF = RING_BYTES, MISC_OFF = LDSCTL_OFF + 320, LDS_BYTES = 147456;
constexpr int MOE_TP_OFF = LDSCTL_OFF + 1024;

#define RLX_AGENT __ATOMIC_RELAXED, __HIP_MEMORY_SCOPE_AGENT
#define LDS_WAIT() asm volatile("s_waitcnt lgkmcnt(0)" ::: "memory")
#define VM_WAIT() asm volatile("s_waitcnt vmcnt(0)" ::: "memory")
__device__ __forceinline__ unsigned cvt_pk_bf16(float lo, float hi) { unsigned r; asm volatile("v_cvt_pk_bf16_f32 %0, %1, %2" : "=v"(r) : "v"(lo), "v"(hi)); return r; }
__device__ __forceinline__ u32x2 pk4(f32x4 v) { u32x2 w; w.x = cvt_pk_bf16(v[0], v[1]); w.y = cvt_pk_bf16(v[2], v[3]); return w; }
__device__ __forceinline__ float bf2f(unsigned short h) { return __uint_as_float((unsigned)h << 16); }
__device__ __forceinline__ float wave_sum(float v) {
#pragma unroll
    for (int o = 1; o < 64; o <<= 1) v += __shfl_xor(v, o);
    return v;
}

#define XB_TMO      128
#define XB_XCNT(j)  (256  + 64 * (j))
#define XB_XSUB(j)  (1280 + 64 * (j))
#define XB_XGEN(j)  (2304 + 64 * (j))
#define XB_TOP      3328
#define XB_TOPGEN   3392
#define XCD_BAR_WORDS 3456
#define XB_SPIN_CAP (1u << 18)
__device__ __forceinline__ unsigned xb_ld(unsigned* p)              { return __hip_atomic_load(p, __ATOMIC_RELAXED, __HIP_MEMORY_SCOPE_AGENT); }
__device__ __forceinline__ unsigned xb_add(unsigned* p, unsigned v) { return __hip_atomic_fetch_add(p, v, __ATOMIC_RELAXED, __HIP_MEMORY_SCOPE_AGENT); }
__device__ __forceinline__ unsigned xb_xcc_id() { return (unsigned)__builtin_amdgcn_s_getreg((3 << 11) | 20) & 0xFu; }
#define XB_SPIN(cond, bar) do { unsigned _sp = 0; while (cond) { __builtin_amdgcn_s_sleep(1); \
    if ((++_sp & 255u) == 0u) { if (xb_ld(&(bar)[XB_TMO])) break; if (_sp > XB_SPIN_CAP) { atomicAdd(&(bar)[XB_TMO], 1u); break; } } } } while (0)
struct XcdBarrier { unsigned* bar; unsigned x; volatile LAS unsigned* st; };
__device__ __forceinline__ XcdBarrier xcd_barrier_post(unsigned* bar, volatile LAS unsigned* st) {
    XcdBarrier b; b.bar = bar; b.x = xb_xcc_id(); b.st = st;
    if (threadIdx.x == 0) (void)xb_add(&bar[XB_XCNT(b.x)], 1u);
    return b;
}
__device__ __forceinline__ void xcd_barrier_complete(unsigned* bar, unsigned x, unsigned& nloc, unsigned& nx) {
    const unsigned G = gridDim.x * gridDim.y * gridDim.z;
    unsigned sum, cnt, mine, sp = 0u;
    for (;;) {
        sum = 0u; cnt = 0u; mine = 0u;
#pragma unroll
        for (unsigned j = 0; j < 16; ++j) { const unsigned c = xb_ld(&bar[XB_XCNT(j)]); sum += c; cnt += (c > 0u) ? 1u : 0u; mine = (j == x) ? c : mine; }
        if (sum == G) break;
        __builtin_amdgcn_s_sleep(1);
        if ((++sp & 255u) == 0u) { if (xb_ld(&bar[XB_TMO])) break; if (sp > XB_SPIN_CAP) { atomicAdd(&bar[XB_TMO], 1u); break; } }
    }
    nloc = mine > 0u ? mine : 1u; nx = cnt > 0u ? cnt : 1u;
}
__device__ __forceinline__ void xcd_barrier(const XcdBarrier& b) {
    asm volatile("s_waitcnt vmcnt(0)" ::: "memory");
    __syncthreads();
    if (threadIdx.x == 0) {
        unsigned* bar = b.bar;
        __builtin_amdgcn_s_waitcnt(0);
        unsigned nloc = b.st[0], nx = b.st[1];
        if (nloc == 0u) { xcd_barrier_complete(bar, b.x, nloc, nx); b.st[0] = nloc; b.st[1] = nx; }
        const unsigned old = xb_add(&bar[XB_XSUB(b.x)], 1u);
        const unsigned gen = old / nloc;
        if (old + 1u == (gen + 1u) * nloc) {
            __builtin_amdgcn_fence(__ATOMIC_RELEASE, "agent");
            asm volatile("s_waitcnt vmcnt(0)" ::: "memory");
            const unsigned og = xb_add(&bar[XB_TOP], 1u);
            const unsigned tg = og / nx;
            if (og + 1u == (tg + 1u) * nx) xb_add(&bar[XB_TOPGEN], 1u);
            else XB_SPIN(xb_ld(&bar[XB_TOPGEN]) == tg, bar);
            __builtin_amdgcn_fence(__ATOMIC_ACQUIRE, "agent");
            xb_add(&bar[XB_XGEN(b.x)], 1u);
            asm volatile("s_waitcnt vmcnt(0)" ::: "memory");
        } else {
            XB_SPIN(xb_ld(&bar[XB_XGEN(b.x)]) == gen, bar);
            __builtin_amdgcn_fence(__ATOMIC_ACQUIRE, "agent");
            asm volatile("s_waitcnt vmcnt(0)" ::: "memory");
        }
    }
    __syncthreads();
}

namespace pg8 {
constexpr int BM = 256, BK = 64, HALF = 128, HTB = HALF * BK * 2, STAGE_BYTES = 8 * HTB;
__host__ __device__ __forceinline__ int lds_byte(int r, int c) { const int st = (r >> 4) * 2 + (c >> 5), rr = r & 15, cc = c & 31, ob = rr * 64 + cc * 2; return st * 1024 + (ob ^ (((ob >> 9) & 1) << 5)); }
__host__ __device__ __forceinline__ void stage_rc(int b, int& R, int& C) { const int st = b / 1024, sb = b % 1024, swz = sb ^ (((sb >> 9) & 1) << 5); R = (st >> 1) * 16 + swz / 64; C = (st & 1) * 32 + (swz % 64) / 2; }

struct Unit { const char* a; const char* b; int crow, ccol, z, e; };

typedef f32x4 Acc[2][2][4][2];

template <class Epi, class Sched, bool ALIGN_EPI, bool GATHER, bool SLOW>
__device__ __forceinline__ void gemm_phase(LAS unsigned char* lds, const int lda, const int ldb, const int K, const Sched& S, const Epi& E) {
    const int tid = threadIdx.x, wid = __builtin_amdgcn_readfirstlane(tid >> 6), lane = tid & 63, wr = wid >> 2, wc = wid & 3, fr = lane & 15, fq = lane >> 4;
    Unit cur, nxt; int ui = 0;
    if (!S.next(0, cur)) return;
    Acc acc;
#define PG8_ZERO() do { _Pragma("unroll") for (int a_ = 0; a_ < 2; ++a_) _Pragma("unroll") for (int b_ = 0; b_ < 2; ++b_) _Pragma("unroll") for (int m_ = 0; m_ < 4; ++m_) _Pragma("unroll") for (int n_ = 0; n_ < 2; ++n_) acc[a_][b_][m_][n_] = (f32x4){0.f, 0.f, 0.f, 0.f}; } while (0)
    if constexpr (SLOW) {
        for (;;) {
            PG8_ZERO();
            unsigned ao[2][4], bo[2][2];
#pragma unroll
            for (int ai = 0; ai < 2; ++ai)
#pragma unroll
                for (int m = 0; m < 4; ++m) { const int row = ai * 128 + wr * 64 + m * 16 + fr; ao[ai][m] = (unsigned)(GATHER ? S.gather_row(cur, row) : row) * (unsigned)lda * 2u + (unsigned)fq * 16u; }
#pragma unroll
            for (int bj = 0; bj < 2; ++bj)
#pragma unroll
                for (int n = 0; n < 2; ++n) bo[bj][n] = (unsigned)(bj * 128 + wc * 32 + n * 16 + fr) * (unsigned)ldb * 2u + (unsigned)fq * 16u;
#pragma unroll 1
            for (int k0 = 0; k0 < K; k0 += 32) {
                bf16x8 af[2][4], bfr[2][2];
#pragma unroll
                for (int ai = 0; ai < 2; ++ai)
#pragma unroll
                    for (int m = 0; m < 4; ++m) af[ai][m] = *(const bf16x8*)(cur.a + ao[ai][m] + (size_t)k0 * 2);
#pragma unroll
                for (int bj = 0; bj < 2; ++bj)
#pragma unroll
                    for (int n = 0; n < 2; ++n) bfr[bj][n] = *(const bf16x8*)(cur.b + bo[bj][n] + (size_t)k0 * 2);
#pragma unroll
                for (int ai = 0; ai < 2; ++ai)
#pragma unroll
                    for (int bj = 0; bj < 2; ++bj)
#pragma unroll
                        for (int m = 0; m < 4; ++m)
#pragma unroll
                            for (int n = 0; n < 2; ++n) acc[ai][bj][m][n] = __builtin_amdgcn_mfma_f32_16x16x32_bf16(bfr[bj][n], af[ai][m], acc[ai][bj][m][n], 0, 0, 0);
            }
            if constexpr (!Epi::AFTER_DRAIN) { E(acc, cur, wr, wc, fr, fq); }
            else { __syncthreads(); E.fused(acc, cur, wr, wc, fr, fq, lds, wid, lane); __syncthreads(); }
            ++ui; if (!S.next(ui, cur)) break;
        }
        return;
    } else {
    const int nt = K / BK;
    unsigned voffA[2], voffB[2], voffC[2];
#pragma unroll
    for (int i = 0; i < 2; ++i) { int R, C; stage_rc(tid * 16 + i * 8192, R, C); voffA[i] = (unsigned)(R * lda + C) * 2u; voffB[i] = (unsigned)(R * ldb + C) * 2u; voffC[i] = (unsigned)C * 2u; }
    const unsigned hstepA = (unsigned)HALF * (unsigned)lda * 2u, hstepB = (unsigned)HALF * (unsigned)ldb * 2u;
    const size_t kstep = (size_t)(BK * 2);
    const unsigned ldsw = (unsigned)wid * 1024u;
    const int aoff = lds_byte(wr * 64 + fr, fq * 8), boff = lds_byte(wc * 32 + fr, fq * 8);
    unsigned vg[2][2];
#define PG8_GROWS(vg, u) do { _Pragma("unroll") for (int h_ = 0; h_ < 2; ++h_) _Pragma("unroll") for (int i_ = 0; i_ < 2; ++i_) { int R_, C_; stage_rc(tid * 16 + i_ * 8192, R_, C_); \
        vg[h_][i_] = (unsigned)S.gather_row(u, h_ * HALF + R_) * (unsigned)lda * 2u + voffC[i_]; } } while (0)
#define PG8_SA(b, h) (((b) * 2 + (h)) * HTB)
#define PG8_SB(b, h) ((4 + (b) * 2 + (h)) * HTB)
#define PG8_GLDS(src, dstoff) __builtin_amdgcn_global_load_lds((const unsigned*)(src), (LAS unsigned*)(lds + (dstoff)), 16, 0, 0)
#define PG8_STAGE_B(bufoff, gbase) do { _Pragma("unroll") for (int _i = 0; _i < 2; ++_i) PG8_GLDS((const char*)(gbase) + voffB[_i], (bufoff) + ldsw + _i * 8192); } while (0)
#define PG8_STAGE_A(bufoff, kptr, h, nx) do { _Pragma("unroll") for (int _i = 0; _i < 2; ++_i) { \
        const unsigned vo_ = GATHER ? vg[h][_i] : (voffA[_i] + (unsigned)(h) * hstepA); PG8_GLDS((const char*)(kptr) + vo_, (bufoff) + ldsw + _i * 8192); } } while (0)
#define PG8_LDA(dst, b, h) do { _Pragma("unroll") for (int m = 0; m < 4; ++m) _Pragma("unroll") for (int k = 0; k < 2; ++k) dst[m][k] = *(const LAS bf16x8*)(lds + PG8_SA(b, h) + aoff + m * 2048 + k * 1024); } while (0)
#define PG8_LDB(dst, b, h) do { _Pragma("unroll") for (int n = 0; n < 2; ++n) _Pragma("unroll") for (int k = 0; k < 2; ++k) dst[n][k] = *(const LAS bf16x8*)(lds + PG8_SB(b, h) + boff + n * 2048 + k * 1024); } while (0)
#define PG8_MMA(ai, bj, At, Bt) do { __builtin_amdgcn_s_setprio(1); _Pragma("unroll") for (int m = 0; m < 4; ++m) _Pragma("unroll") for (int n = 0; n < 2; ++n) _Pragma("unroll") for (int k = 0; k < 2; ++k) \
        acc[ai][bj][m][n] = __builtin_amdgcn_mfma_f32_16x16x32_bf16(Bt[n][k], At[m][k], acc[ai][bj][m][n], 0, 0, 0); __builtin_amdgcn_s_setprio(0); } while (0)
#define PG8_WAIT_V(n) asm volatile("s_waitcnt vmcnt(" #n ")" ::: "memory")
#define PG8_WAIT_L(n) asm volatile("s_waitcnt lgkmcnt(" #n ")" ::: "memory")
#define PG8_BAR __builtin_amdgcn_s_barrier()
#define PG8_SCHED __builtin_amdgcn_sched_barrier(0)
    PG8_ZERO();
    bf16x8 At[4][2], B0[2][2], B1[2][2];
    const char* cA = cur.a; const char* cB = cur.b;
    if constexpr (GATHER) { PG8_GROWS(vg, cur); }
    PG8_STAGE_B(PG8_SB(0, 0), cB); PG8_STAGE_B(PG8_SB(0, 1), cB + hstepB); PG8_STAGE_A(PG8_SA(0, 0), cA, 0, false); PG8_STAGE_A(PG8_SA(0, 1), cA, 1, false);
    if (wr == 1) PG8_BAR;
    PG8_WAIT_V(2); PG8_BAR;
    PG8_STAGE_B(PG8_SB(1, 0), cB + kstep); PG8_STAGE_A(PG8_SA(1, 0), cA + kstep, 0, false); PG8_STAGE_B(PG8_SB(1, 1), cB + hstepB + kstep);
    PG8_WAIT_V(6); PG8_BAR;
    for (;;) {
        const bool has_next = S.next(ui + 1, nxt);
        const char* nA = has_next ? nxt.a : cA; const char* nB = has_next ? nxt.b : cB;
        for (int t = 0; t < nt; t += 2) {
            const bool last = (t == nt - 2);
            const char* a1 = cA + (size_t)(t + 1) * kstep;
            const char* a2 = last ? nA : cA + (size_t)(t + 2) * kstep; const char* b2 = last ? nB : cB + (size_t)(t + 2) * kstep;
            const char* a3 = a2 + kstep; const char* b3 = b2 + kstep;
            PG8_LDB(B0, 0, 0); PG8_LDB(B1, 0, 1); PG8_SCHED; PG8_LDA(At, 0, 0); PG8_STAGE_A(PG8_SA(1, 1), a1, 1, false);
            if constexpr (GATHER) { if (last && has_next) { PG8_GROWS(vg, nxt); } }
            PG8_WAIT_V(8); PG8_WAIT_L(0); PG8_BAR; PG8_MMA(0, 0, At, B0); PG8_MMA(0, 1, At, B1); PG8_BAR; PG8_SCHED;
            PG8_LDA(At, 0, 1); PG8_STAGE_B(PG8_SB(0, 0), b2); PG8_STAGE_B(PG8_SB(0, 1), b2 + hstepB); PG8_STAGE_A(PG8_SA(0, 0), a2, 0, last);
            PG8_WAIT_V(8); PG8_WAIT_L(0); PG8_BAR; PG8_MMA(1, 0, At, B0); PG8_MMA(1, 1, At, B1); PG8_BAR; PG8_SCHED;
            PG8_LDB(B0, 1, 0); PG8_LDB(B1, 1, 1); PG8_SCHED; PG8_LDA(At, 1, 0); PG8_STAGE_A(PG8_SA(0, 1), a2, 1, last);
            PG8_WAIT_V(8); PG8_WAIT_L(0); PG8_BAR; PG8_MMA(0, 0, At, B0); PG8_MMA(0, 1, At, B1); PG8_BAR; PG8_SCHED;
            PG8_LDA(At, 1, 1); PG8_STAGE_B(PG8_SB(1, 0), b3); PG8_STAGE_B(PG8_SB(1, 1), b3 + hstepB); PG8_STAGE_A(PG8_SA(1, 0), a3, 0, last);
            PG8_WAIT_V(8); PG8_WAIT_L(0); PG8_BAR; PG8_MMA(1, 0, At, B0); PG8_MMA(1, 1, At, B1); PG8_BAR; PG8_SCHED;
        }
        if constexpr (ALIGN_EPI) { if (wr == 0) PG8_BAR; }
        if constexpr (!Epi::AFTER_DRAIN) { E(acc, cur, wr, wc, fr, fq); }
        if (!has_next) break;
        PG8_ZERO();
        cur = nxt; cA = nA; cB = nB; ++ui;
        if constexpr (ALIGN_EPI) { if (wr == 1) PG8_BAR; }
    }
    PG8_WAIT_V(0);
    if constexpr (!ALIGN_EPI) { if (wr == 0) PG8_BAR; }
    PG8_BAR;
    if constexpr (Epi::AFTER_DRAIN) { E.fused(acc, cur, wr, wc, fr, fq, lds, wid, lane); }
#undef PG8_SA
#undef PG8_SB
#undef PG8_GLDS
#undef PG8_STAGE_A
#undef PG8_STAGE_B
#undef PG8_LDA
#undef PG8_LDB
#undef PG8_MMA
#undef PG8_WAIT_V
#undef PG8_WAIT_L
#undef PG8_BAR
#undef PG8_SCHED
#undef PG8_GROWS
    }
#undef PG8_ZERO
}
}
using pg8::Unit; using pg8::Acc;

struct DenseSched {
    const char* A; const char* Bt; int lda, ldb, nM, nN, nwg, G, c;
    __device__ __forceinline__ void init(const void* A_, const void* Bt_, int lda_, int ldb_, int M, int N, int G_, int c_) { A = (const char*)A_; Bt = (const char*)Bt_; lda = lda_; ldb = ldb_; nM = M / 256; nN = N / 256; nwg = nM * nN; G = G_; c = c_; }
    __device__ __forceinline__ bool next(int i, Unit& u) const {
        const long L = (long)i * G + c; if (L >= nwg) return false;
        int wgid = (int)L; { const int q = nwg / 8, r = nwg % 8, xcd = wgid % 8, off = wgid / 8; wgid = (xcd < r ? xcd * (q + 1) : r * (q + 1) + (xcd - r) * q) + off; }
        const int nig = 8 * nN, gid = wgid / nig, fm = gid * 8, gsz = (nM - fm) < 8 ? (nM - fm) : 8;
        const int pm = fm + ((wgid % nig) % gsz), pn = (wgid % nig) / gsz;
        u.a = A + (size_t)pm * 256 * lda * 2; u.b = Bt + (size_t)pn * 256 * ldb * 2; u.crow = pm * 256; u.ccol = pn * 256; u.z = pn; u.e = 0; return true;
    }
    __device__ __forceinline__ int gather_row(const Unit&, int r) const { return r; }
};
struct DftSched {
    const char* dftm; const char* vtt; int c;
    __device__ __forceinline__ bool next(int i, Unit& u) const {
        if (i > 0 || c >= 256) return false;
        const int x = c & 7, y = c >> 3, b = x >> 1, pn = x & 1, pm = y >> 1, part = y & 1;
        u.a = dftm + ((size_t)(pm * 256) * 8192 + part * 4096) * 2; u.b = vtt + ((size_t)(b * 512 + pn * 256) * 8192 + part * 4096) * 2;
        u.crow = part * T + b * SEQ + pm * 256; u.ccol = pn * 256; u.z = part; u.e = 0; return true;
    }
    __device__ __forceinline__ int gather_row(const Unit&, int r) const { return r; }
};
template <int MODE> struct AttnSched {
    const char* A; const char* B; int c;
    __device__ __forceinline__ bool next(int i, Unit& u) const {
        if (i > 0 || c >= 256) return false;
        const int vc = (c & 7) * 32 + (c >> 3);
        const int bh = vc >> 4, pm = vc & 15, b = bh >> 2, h = bh & 3;
        u.a = A + ((size_t)(b * SEQ + pm * 256) * D + h * 256) * 2;
        u.b = MODE == 0 ? B + ((size_t)(b * MEML) * D + h * 256) * 2 : B + ((size_t)(b * D + h * 256) * MEML) * 2;
        u.crow = b * SEQ + pm * 256; u.ccol = h * 256; u.z = bh; u.e = 0; return true;
    }
    __device__ __forceinline__ int gather_row(const Unit&, int r) const { return r; }
};
template <int MODE  > struct MoeSched {
    const char* A; const char* Bw; const int* list; const LAS int* tp; const LAS int* cnt; const LAS int* base; int G, c;
    __device__ __forceinline__ bool next(int i, Unit& u) const {
        const int L = i * G + c; const int tile = L >> 2, pn = L & 3;
        if (tile >= tp[NEXP]) return false;
        int e = 0;
        for (int j = 1; j < NEXP; ++j) e += (tp[j] <= tile) ? 1 : 0;
        const int mt = tile - tp[e];
        u.e = e; u.z = mt; u.crow = base[e] + mt * 256; u.ccol = pn * 256;
        if (MODE == 0) { u.a = A; u.b = Bw + ((size_t)e * 1024 + pn * 256) * D * 2; }
        else { u.a = A + (size_t)(base[e] + mt * 256) * DEXP * 2; u.b = Bw + ((size_t)e * D + pn * 256) * DEXP * 2; }
        return true;
    }
    __device__ __forceinline__ int gather_row(const Unit& u, int r) const {
        const int p = u.z * 256 + r; return p < cnt[u.e] ? (list[u.e * T + p] >> 1) : 0;
    }
};

#define EPI_ROW(ai, m) ((ai) * 128 + wr * 64 + (m) * 16 + fr)
#define EPI_COL(bj, n) ((bj) * 128 + wc * 32 + (n) * 16 + 4 * fq)
struct EpiMix {
    static constexpr bool AFTER_DRAIN = false;
    const float* rstd0; bf16_t* bg; bf16_t* cv; bf16_t* uf;
    __device__ __forceinline__ void operator()(const Acc& acc, const Unit& u, int wr, int wc, int fr, int fq) const {
        const int ch = u.z * 64 + wc * 16 + 4 * fq;
#pragma unroll
        for (int ai = 0; ai < 2; ++ai)
#pragma unroll
            for (int m = 0; m < 4; ++m) { const int row = u.crow + EPI_ROW(ai, m); const float r = rstd0[row];
                const f32x4 b = acc[ai][0][m][0] * r, c = acc[ai][0][m][1] * r, v = acc[ai][1][m][0] * r, f = acc[ai][1][m][1] * r;
                const size_t o = (size_t)row * 512 + ch;
                *(u32x2*)(bg + o) = pk4(b); *(u32x2*)(cv + o) = pk4(c * v); *(u32x2*)(uf + o) = pk4(f); }
    }
};
struct EpiKV {
    static constexpr bool AFTER_DRAIN = false;
    const float* rstdm; bf16_t* kb; bf16_t* vt;
    __device__ __forceinline__ void operator()(const Acc& acc, const Unit& u, int wr, int wc, int fr, int fq) const {
#pragma unroll
        for (int ai = 0; ai < 2; ++ai)
#pragma unroll
            for (int m = 0; m < 4; ++m) { const int row = u.crow + EPI_ROW(ai, m); const float r = rstdm[row];
#pragma unroll
                for (int bj = 0; bj < 2; ++bj)
#pragma unroll
                    for (int n = 0; n < 2; ++n) { const int col = u.ccol + EPI_COL(bj, n); const f32x4 v = acc[ai][bj][m][n] * r;
                        if (col < D) *(u32x2*)(kb + (size_t)row * D + col) = pk4(v);
                        else { const int b = row >> 8, key = row & 255; const u32x2 w = pk4(v); bf16_t* p = vt + ((size_t)b * D + (col - D)) * MEML + key;
                            p[0] = (bf16_t)(w.x & 0xffffu); p[MEML] = (bf16_t)(w.x >> 16); p[2 * MEML] = (bf16_t)(w.y & 0xffffu); p[3 * MEML] = (bf16_t)(w.y >> 16); } } }
    }
};
struct EpiF32 {
    static constexpr bool AFTER_DRAIN = false;
    float* C; int ldc;
    __device__ __forceinline__ void operator()(const Acc& acc, const Unit& u, int wr, int wc, int fr, int fq) const {
#pragma unroll
        for (int ai = 0; ai < 2; ++ai)
#pragma unroll
            for (int m = 0; m < 4; ++m) { float* rowp = C + (size_t)(u.crow + EPI_ROW(ai, m)) * ldc + u.ccol;
#pragma unroll
                for (int bj = 0; bj < 2; ++bj)
#pragma unroll
                    for (int n = 0; n < 2; ++n) *(f32x4*)(rowp + EPI_COL(bj, n)) = acc[ai][bj][m][n]; }
    }
};
struct EpiBf16 {
    static constexpr bool AFTER_DRAIN = false;
    bf16_t* O; int ldc; const float* ssq; float cs;
    __device__ __forceinline__ void operator()(const Acc& acc, const Unit& u, int wr, int wc, int fr, int fq) const {
#pragma unroll
        for (int ai = 0; ai < 2; ++ai)
#pragma unroll
            for (int m = 0; m < 4; ++m) { const int row = u.crow + EPI_ROW(ai, m); float r = cs;
                if (ssq) r *= rsqrtf(((ssq[row] + ssq[T + row]) + (ssq[2 * T + row] + ssq[3 * T + row])) * (1.f / D) + EPS);
                bf16_t* rowp = O + (size_t)row * ldc + u.ccol;
#pragma unroll
                for (int bj = 0; bj < 2; ++bj)
#pragma unroll
                    for (int n = 0; n < 2; ++n) *(u32x2*)(rowp + EPI_COL(bj, n)) = pk4(acc[ai][bj][m][n] * r); }
    }
};
struct EpiRes {
    static constexpr bool AFTER_DRAIN = true;
    const float* xin; float* xo; bf16_t* xb; float* ssq;
    __device__ __forceinline__ void fused(Acc& acc, const Unit& u, int wr, int wc, int fr, int fq, LAS unsigned char* lds, int wid, int lane) const {
        LAS float* P = (LAS float*)lds;
#pragma unroll
        for (int ai = 0; ai < 2; ++ai)
#pragma unroll
            for (int m = 0; m < 4; ++m) { const int rl = EPI_ROW(ai, m); const size_t ro = (size_t)(u.crow + rl) * D + u.ccol; float s = 0.f;
#pragma unroll
                for (int bj = 0; bj < 2; ++bj)
#pragma unroll
                    for (int n = 0; n < 2; ++n) { const size_t o = ro + EPI_COL(bj, n); const f32x4 v = *(const f32x4*)(xin + o) + acc[ai][bj][m][n];
                        *(f32x4*)(xo + o) = v; *(u32x2*)(xb + o) = pk4(v); s += (v[0] * v[0] + v[1] * v[1]) + (v[2] * v[2] + v[3] * v[3]); }
                s += __shfl_xor(s, 16); s += __shfl_xor(s, 32);
                if (fq == 0) P[rl * 4 + wc] = s; }
        LDS_WAIT(); __syncthreads();
        const int tid = wid * 64 + lane;
        if (tid < 256) ssq[(size_t)u.z * T + u.crow + tid] = (P[tid * 4 + 0] + P[tid * 4 + 1]) + (P[tid * 4 + 2] + P[tid * 4 + 3]);
        LDS_WAIT(); __syncthreads();
    }
};
struct EpiSoftmax {
    static constexpr bool AFTER_DRAIN = true;
    bf16_t* Pm;
    __device__ __forceinline__ void fused(Acc& acc, const Unit& u, int wr, int wc, int fr, int fq, LAS unsigned char* lds, int wid, int lane) const {
        LAS float* PM = (LAS float*)lds; LAS float* PS = (LAS float*)(lds + 4096);
#pragma unroll
        for (int ai = 0; ai < 2; ++ai)
#pragma unroll
            for (int m = 0; m < 4; ++m) { float mx = -1e30f;
#pragma unroll
                for (int bj = 0; bj < 2; ++bj)
#pragma unroll
                    for (int n = 0; n < 2; ++n) { const f32x4 v = acc[ai][bj][m][n]; mx = fmaxf(mx, fmaxf(fmaxf(v[0], v[1]), fmaxf(v[2], v[3]))); }
                mx = fmaxf(mx, __shfl_xor(mx, 16)); mx = fmaxf(mx, __shfl_xor(mx, 32));
                if (fq == 0) PM[EPI_ROW(ai, m) * 4 + wc] = mx; }
        LDS_WAIT(); __syncthreads();
#pragma unroll
        for (int ai = 0; ai < 2; ++ai)
#pragma unroll
            for (int m = 0; m < 4; ++m) { const int rl = EPI_ROW(ai, m); const float mx = fmaxf(fmaxf(PM[rl * 4], PM[rl * 4 + 1]), fmaxf(PM[rl * 4 + 2], PM[rl * 4 + 3])); float s = 0.f;
#pragma unroll
                for (int bj = 0; bj < 2; ++bj)
#pragma unroll
                    for (int n = 0; n < 2; ++n) { f32x4 v = acc[ai][bj][m][n];
#pragma unroll
                        for (int i = 0; i < 4; ++i) { v[i] = __builtin_amdgcn_exp2f(v[i] - mx); s += v[i]; }
                        acc[ai][bj][m][n] = v; }
                s += __shfl_xor(s, 16); s += __shfl_xor(s, 32);
                if (fq == 0) PS[rl * 4 + wc] = s; }
        LDS_WAIT(); __syncthreads();
#pragma unroll
        for (int ai = 0; ai < 2; ++ai)
#pragma unroll
            for (int m = 0; m < 4; ++m) { const int rl = EPI_ROW(ai, m); const float inv = 1.f / ((PS[rl * 4] + PS[rl * 4 + 1]) + (PS[rl * 4 + 2] + PS[rl * 4 + 3]));
                bf16_t* rowp = Pm + (size_t)(u.crow + rl) * D + u.ccol;
#pragma unroll
                for (int bj = 0; bj < 2; ++bj)
#pragma unroll
                    for (int n = 0; n < 2; ++n) *(u32x2*)(rowp + EPI_COL(bj, n)) = pk4(acc[ai][bj][m][n] * inv); }
        LDS_WAIT(); __syncthreads();
    }
};
struct EpiGU {
    static constexpr bool AFTER_DRAIN = false;
    const int* list; const LAS int* cnt; const float* rstd2; bf16_t* hmid;
    __device__ __forceinline__ void operator()(const Acc& acc, const Unit& u, int wr, int wc, int fr, int fq) const {
        const int pn = u.ccol >> 8;
#pragma unroll
        for (int ai = 0; ai < 2; ++ai)
#pragma unroll
            for (int m = 0; m < 4; ++m) { const int rl = EPI_ROW(ai, m), p = u.z * 256 + rl;
                if (p < cnt[u.e]) { const int tok = list[u.e * T + p] >> 1; const float r = rstd2[tok];
#pragma unroll
                    for (int bj = 0; bj < 2; ++bj) { const f32x4 a = acc[ai][bj][m][0] * r, b = acc[ai][bj][m][1] * r; f32x4 h;
#pragma unroll
                        for (int i = 0; i < 4; ++i) h[i] = a[i] / (1.f + __expf(-a[i])) * b[i];
                        *(u32x2*)(hmid + (size_t)(u.crow + rl) * DEXP + pn * 128 + bj * 64 + wc * 16 + 4 * fq) = pk4(h); } } }
    }
};
struct EpiDown {
    static constexpr bool AFTER_DRAIN = false;
    const int* list; const LAS int* cnt; const float* tokg; bf16_t* y0; bf16_t* y1;
    __device__ __forceinline__ void operator()(const Acc& acc, const Unit& u, int wr, int wc, int fr, int fq) const {
#pragma unroll
        for (int ai = 0; ai < 2; ++ai)
#pragma unroll
            for (int m = 0; m < 4; ++m) { const int rl = EPI_ROW(ai, m), p = u.z * 256 + rl;
                if (p < cnt[u.e]) { const int ent = list[u.e * T + p]; const float g = tokg[ent]; bf16_t* rowp = ((ent & 1) ? y1 : y0) + (size_t)(ent >> 1) * D + u.ccol;
#pragma unroll
                    for (int bj = 0; bj < 2; ++bj)
#pragma unroll
                        for (int n = 0; n < 2; ++n) *(u32x2*)(rowp + EPI_COL(bj, n)) = pk4(acc[ai][bj][m][n] * g); } }
    }
};

struct Args { const float* in[22]; float* out; unsigned char* ws; int ph_lo, ph_hi; };
struct Frame { LAS unsigned char* lds; volatile LAS unsigned* MISC; gu32* ctl; int tid, lane, wave, vcu, G; };

template <int MAP> __device__ __forceinline__ int dest_row(int n) {
    if (MAP == 0) return n;
    if (MAP == 1) { const int sec = n < 1536 ? n / 512 : 3, within = n < 1536 ? n % 512 : n - 1536, pn = within >> 6, ch = within & 63;
        return pn * 256 + 128 * (sec >> 1) + 32 * (ch >> 4) + 16 * (sec & 1) + (ch & 15); }
    const int pn = n >> 7, bj = (n >> 6) & 1, wc = (n >> 4) & 3; return pn * 256 + 128 * bj + 32 * wc + 16 * (MAP == 3 ? 1 : 0) + (n & 15);
}
template <int MAP> __device__ __forceinline__ void transpose_item(const float* W, int K, int N, bf16_t* WT, const float* gk, LAS float* scr, int item, int lane) {
    const int nblk = N / 32, kb = item / nblk, nb = item % nblk, k0 = 64 * kb, n0 = 32 * nb;
#pragma unroll 8
    for (int i = 0; i < 32; ++i) { const int kk = 2 * i + (lane >> 5); float v = W[(size_t)(k0 + kk) * N + n0 + (lane & 31)]; if (gk) v *= gk[k0 + kk]; scr[kk * 33 + (lane & 31)] = v; }
    LDS_WAIT(); asm volatile("" ::: "memory");
    const int c = lane & 7;
#pragma unroll
    for (int j = 0; j < 4; ++j) { const int n = (lane >> 3) + 8 * j; const LAS float* s = scr + (8 * c) * 33 + n;
        u32x4 o; o.x = cvt_pk_bf16(s[0 * 33], s[1 * 33]); o.y = cvt_pk_bf16(s[2 * 33], s[3 * 33]); o.z = cvt_pk_bf16(s[4 * 33], s[5 * 33]); o.w = cvt_pk_bf16(s[6 * 33], s[7 * 33]);
        *(GAS u32x4*)(WT + (size_t)dest_row<MAP>(n0 + n) * K + k0 + 8 * c) = o; }
    LDS_WAIT(); asm volatile("" ::: "memory");
}
__device__ __forceinline__ void row_to_bf16(const float* xrow, bf16_t* orow, float* rstd, int lane) {
    const GAS f32x4* xr = (const GAS f32x4*)xrow + lane; f32x4 v[4]; float s = 0.f;
#pragma unroll
    for (int j = 0; j < 4; ++j) { v[j] = xr[64 * j]; s += (v[j].x * v[j].x + v[j].y * v[j].y) + (v[j].z * v[j].z + v[j].w * v[j].w); }
    s = wave_sum(s);
    GAS u32x2* o8 = (GAS u32x2*)orow + lane;
#pragma unroll
    for (int j = 0; j < 4; ++j) o8[64 * j] = pk4(v[j]);
    if (lane == 0) *rstd = rsqrtf(s * (1.f / D) + EPS);
}

__global__ void __launch_bounds__(NWAVES * 64, 2) mk_fwd(Args args) {
    extern __shared__ __attribute__((aligned(16))) unsigned char lds_raw[];
    Frame F; F.lds = (LAS unsigned char*)lds_raw; F.MISC = (volatile LAS unsigned*)(F.lds + MISC_OFF);
    F.tid = threadIdx.x; F.lane = F.tid & 63; F.wave = __builtin_amdgcn_readfirstlane(F.tid >> 6);
    F.G = gridDim.x; { const int bx = blockIdx.x; F.vcu = (F.G % 8 == 0) ? (bx % 8) * (F.G / 8) + bx / 8 : bx; }
    F.ctl = (gu32*)(args.ws + WS_CTL);
#define p_x (args.in[0])
#define p_mem (args.in[1])
#define p_norm_mix_g (args.in[2])
#define p_w_in (args.in[3])
#define p_conv_w (args.in[4])
#define p_conv_b (args.in[5])
#define p_head_norm_g (args.in[6])
#define p_w_out (args.in[7])
#define p_norm_xa_g (args.in[8])
#define p_norm_mem_g (args.in[9])
#define p_w_q (args.in[10])
#define p_w_kv (args.in[11])
#define p_w_o (args.in[12])
#define p_norm_ffn_g (args.in[13])
#define p_w_rg (args.in[14])
#define p_b_rg (args.in[15])
#define p_w_re (args.in[16])
#define p_b_re (args.in[17])
#define p_w_gate (args.in[18])
#define p_w_up (args.in[19])
#define p_w_down (args.in[20])
#define p_final_g (args.in[21])
#define WSP(type, off) ((type*)(args.ws + (off)))
#define Win_t  WSP(bf16_t, WS_WIN)
#define Wout_t WSP(bf16_t, WS_WOUT)
#define Wq_t   WSP(bf16_t, WS_WQ)
#define Wkv_t  WSP(bf16_t, WS_WKV)
#define Wo_t   WSP(bf16_t, WS_WO)
#define KB     WSP(bf16_t, WS_KB)
#define VT     WSP(bf16_t, WS_VT)
#define MB     WSP(bf16_t, WS_MB)
#define LIST   WSP(int, WS_LIST)
#define rstd0  WSP(float, WS_MISC + MS_RSTD0)
#define rstdm  WSP(float, WS_MISC + MS_RSTDM)
#define ssq1   WSP(float, WS_MISC + MS_SSQ1)
#define ssq2   WSP(float, WS_MISC + MS_SSQ2)
#define rstd2  WSP(float, WS_MISC + MS_RSTD2)
#define tokg   WSP(float, WS_MISC + MS_TOKG)
#define WR     WSP(float, WS_MISC + MS_WR)
#define X1     WSP(float, WS_X1)
#define UF     WSP(bf16_t, WS_UF)
#define YPART  WSP(float, WS_YPART)
#define ACT0   WSP(bf16_t, WS_ACT0)
#define ACT1   WSP(bf16_t, WS_ACT1)
#define DFTM   WSP(bf16_t, WS_DFTM)
#define VTT    WSP(bf16_t, WS_VTT)
#define WGU    WSP(bf16_t, WS_WGU)
#define WD     WSP(bf16_t, WS_WD)
#define BG     WSP(bf16_t, WS_BG)
#define CV     WSP(bf16_t, WS_CV)
#define Y1     WSP(bf16_t, WS_Y1)
#define CNT    (WSP(int, WS_CTL) + CW_CNT)
    for (int u = F.tid; u < (LDS_BYTES - LDSCTL_OFF) / 4; u += NWAVES * 64) ((LAS unsigned*)(F.lds + LDSCTL_OFF))[u] = 0u;
    __syncthreads();
    XcdBarrier bar = xcd_barrier_post((unsigned*)(F.ctl + CW_BAR), F.MISC + 8);
    const int lo = args.ph_lo, hi = args.ph_hi;
#ifndef MK_MASK
#define MK_MASK 0xffffffffu
#endif
#define IN(k) (((MK_MASK >> (k)) & 1u) && lo <= (k) && (k) < hi)
#define SEAM(k) do { if (IN(k) && IN((k) + 1)) xcd_barrier(bar); } while (0)
    const int gw = F.vcu * NWAVES + F.wave, NGW = F.G * NWAVES;
    constexpr bool SLOW = (MK_SLOW != 0);

    if (IN(0)) {
        LAS float* scr = (LAS float*)(F.lds + F.wave * 8704);
        LAS float* tab = (LAS float*)(F.lds + 98304);
        for (int i = F.tid; i < 4096; i += NWAVES * 64) { tab[i] = cospif((float)i * (1.f / 2048.f)); tab[4096 + i] = sinpif((float)i * (1.f / 2048.f)); }
        constexpr int I_IN = 16 * 64, I_SQ = 16 * 32, I_KV = 16 * 64;
        for (int it = gw; it < I_IN + 3 * I_SQ + I_KV; it += NGW) { int r = it;
            if (r < I_IN) { transpose_item<1>(p_w_in, D, INCOLS, Win_t, p_norm_mix_g, scr, r, F.lane); continue; } r -= I_IN;
            if (r < I_SQ) { transpose_item<0>(p_w_out, D, D, Wout_t, nullptr, scr, r, F.lane); continue; } r -= I_SQ;
            if (r < I_SQ) { transpose_item<0>(p_w_q, D, D, Wq_t, p_norm_xa_g, scr, r, F.lane); continue; } r -= I_SQ;
            if (r < I_SQ) { transpose_item<0>(p_w_o, D, D, Wo_t, nullptr, scr, r, F.lane); continue; } r -= I_SQ;
            transpose_item<0>(p_w_kv, D, 2 * D, Wkv_t, p_norm_mem_g, scr, r, F.lane); }
        for (int m = gw; m < T; m += NGW) row_to_bf16(p_x + (size_t)m * D, ACT0 + (size_t)m * D, rstd0 + m, F.lane);
        for (int m = gw; m < NB * MEML; m += NGW) row_to_bf16(p_mem + (size_t)m * D, MB + (size_t)m * D, rstdm + m, F.lane);
        for (int i = blockIdx.x * (NWAVES * 64) + F.tid; i < D * 48; i += F.G * NWAVES * 64) { const int k = i / 48, j = i % 48; WR[i] = j < 4 ? p_norm_ffn_g[k] * p_w_rg[k * 4 + j] : (j < 36 ? p_norm_ffn_g[k] * p_w_re[k * 32 + j - 4] : 0.f); }
        __syncthreads();
        for (int m = gw; m < SEQ; m += NGW) {
            for (int ch = F.lane; ch < 1024; ch += 64) { const int k0 = ch * 8; const int part = k0 >> 12, s0 = k0 & 4095; float v[8];
#pragma unroll
                for (int j = 0; j < 8; ++j) v[j] = tab[part * 4096 + ((m * (s0 + j)) & 4095)];
                u32x4 o; o.x = cvt_pk_bf16(v[0], v[1]); o.y = cvt_pk_bf16(v[2], v[3]); o.z = cvt_pk_bf16(v[4], v[5]); o.w = cvt_pk_bf16(v[6], v[7]);
                *(GAS u32x4*)(DFTM + (size_t)m * 8192 + k0) = o; } }
        __syncthreads();
    }
    SEAM(0);
    if (IN(1)) {
        { DenseSched S; S.init(ACT0, Win_t, D, D, T, INCOLS, F.G, (int)blockIdx.x); EpiMix E{rstd0, BG, CV, UF};
          pg8::gemm_phase<EpiMix, DenseSched, true, false, SLOW>(F.lds, D, D, D, S, E); }
        { DenseSched S; S.init(MB, Wkv_t, D, D, NB * MEML, 2 * D, F.G, (int)blockIdx.x); EpiKV E{rstdm, KB, VT};
          pg8::gemm_phase<EpiKV, DenseSched, true, false, SLOW>(F.lds, D, D, D, S, E); }
    }
    SEAM(1);
    if (IN(2)) {
        bf16x8 fm[8][2];
#pragma unroll
        for (int ni = 0; ni < 8; ++ni)
#pragma unroll
            for (int kk = 0; kk < 2; ++kk) { unsigned w[4];
#pragma unroll
                for (int j2 = 0; j2 < 4; ++j2) { float v[2];
#pragma unroll
                    for (int q = 0; q < 2; ++q) { const int c = kk * 32 + (F.lane >> 4) * 8 + j2 * 2 + q, cc = ni * 16 + (F.lane & 15), cp = cc & 63; const float ang = (float)((c * cp) & 63) * (1.f / 32.f);
                        v[q] = (cc < 64 ? cospif(ang) : -sinpif(ang)) * (1.f / 512.f); }
                    w[j2] = cvt_pk_bf16(v[0], v[1]); }
                fm[ni][kk] = __builtin_bit_cast(bf16x8, (u32x4){w[0], w[1], w[2], w[3]}); }
        for (int it = gw; it < (T / 16) * 8; it += NGW) { const int tb = it >> 3, g = it & 7, t0 = tb * 16, b = t0 / SEQ, s0 = t0 % SEQ;
            bf16x8 a[2];
#pragma unroll
            for (int kk = 0; kk < 2; ++kk) a[kk] = *(const bf16x8*)(UF + (size_t)(t0 + (F.lane & 15)) * 512 + g * 64 + kk * 32 + (F.lane >> 4) * 8);
#pragma unroll
            for (int ni = 0; ni < 8; ++ni) { f32x4 d = {0.f, 0.f, 0.f, 0.f};
                d = __builtin_amdgcn_mfma_f32_16x16x32_bf16(a[0], fm[ni][0], d, 0, 0, 0); d = __builtin_amdgcn_mfma_f32_16x16x32_bf16(a[1], fm[ni][1], d, 0, 0, 0);
                const int cc = ni * 16 + (F.lane & 15), part = cc >> 6, cp = cc & 63;
                *(u32x2*)(VTT + ((size_t)(b * 512 + g * 64 + cp) * 8192 + part * 4096 + s0 + 4 * (F.lane >> 4))) = pk4(d); } }
    }
    SEAM(2);
    if (IN(3)) { DftSched S{(const char*)DFTM, (const char*)VTT, (int)blockIdx.x}; EpiF32 E{YPART, 512};
        pg8::gemm_phase<EpiF32, DftSched, false, false, SLOW>(F.lds, 8192, 8192, 4096, S, E); }
    SEAM(3);
    if (IN(4)) {
        for (int t = gw; t < T; t += NGW) { const int s = t % SEQ, l = F.lane, c0 = 8 * l;
            const bf16x8 bgv = *(const bf16x8*)(BG + (size_t)t * 512 + c0), cv0 = *(const bf16x8*)(CV + (size_t)t * 512 + c0);
            bf16x8 cvm = {0, 0, 0, 0, 0, 0, 0, 0}, cvp = {0, 0, 0, 0, 0, 0, 0, 0};
            if (s > 0) cvm = *(const bf16x8*)(CV + (size_t)(t - 1) * 512 + c0);
            if (s < SEQ - 1) cvp = *(const bf16x8*)(CV + (size_t)(t + 1) * 512 + c0);
            float y[8], f[8]; float sy = 0.f, sf = 0.f;
#pragma unroll
            for (int j = 0; j < 8; ++j) { const int c = c0 + j;
                const float z = p_conv_b[c] + bf2f((unsigned short)cvm[j]) * p_conv_w[c] + bf2f((unsigned short)cv0[j]) * p_conv_w[512 + c] + bf2f((unsigned short)cvp[j]) * p_conv_w[1024 + c];
                y[j] = bf2f((unsigned short)bgv[j]) * z; sy += y[j] * y[j];
                f[j] = YPART[(size_t)t * 512 + c] + YPART[(size_t)(T + t) * 512 + c]; sf += f[j] * f[j]; }
            sy += __shfl_xor(sy, 1); sy += __shfl_xor(sy, 2); sy += __shfl_xor(sy, 4); sf += __shfl_xor(sf, 1); sf += __shfl_xor(sf, 2); sf += __shfl_xor(sf, 4);
            const float ry = rsqrtf(sy * (1.f / 64.f) + EPS), rf = rsqrtf(sf * (1.f / 64.f) + EPS);
            u32x4 oy, of;
            oy.x = cvt_pk_bf16(y[0] * ry * p_head_norm_g[c0 + 0], y[1] * ry * p_head_norm_g[c0 + 1]); oy.y = cvt_pk_bf16(y[2] * ry * p_head_norm_g[c0 + 2], y[3] * ry * p_head_norm_g[c0 + 3]);
            oy.z = cvt_pk_bf16(y[4] * ry * p_head_norm_g[c0 + 4], y[5] * ry * p_head_norm_g[c0 + 5]); oy.w = cvt_pk_bf16(y[6] * ry * p_head_norm_g[c0 + 6], y[7] * ry * p_head_norm_g[c0 + 7]);
            of.x = cvt_pk_bf16(f[0] * rf * p_head_norm_g[512 + c0 + 0], f[1] * rf * p_head_norm_g[512 + c0 + 1]); of.y = cvt_pk_bf16(f[2] * rf * p_head_norm_g[512 + c0 + 2], f[3] * rf * p_head_norm_g[512 + c0 + 3]);
            of.z = cvt_pk_bf16(f[4] * rf * p_head_norm_g[512 + c0 + 4], f[5] * rf * p_head_norm_g[512 + c0 + 5]); of.w = cvt_pk_bf16(f[6] * rf * p_head_norm_g[512 + c0 + 6], f[7] * rf * p_head_norm_g[512 + c0 + 7]);
            *(u32x4*)(ACT1 + (size_t)t * D + c0) = oy; *(u32x4*)(ACT1 + (size_t)t * D + 512 + c0) = of; }
        LAS float* scr = (LAS float*)(F.lds + F.wave * 8704);
        constexpr int I_G = 16 * 16, I_D = 8 * 32;
        for (int it = gw; it < NEXP * (2 * I_G + I_D); it += NGW) { const int e = it / (2 * I_G + I_D); int r = it % (2 * I_G + I_D);
            if (r < I_G) { transpose_item<2>(p_w_gate + (size_t)e * D * DEXP, D, DEXP, WGU + (size_t)e * 1024 * D, p_norm_ffn_g, scr, r, F.lane); continue; } r -= I_G;
            if (r < I_G) { transpose_item<3>(p_w_up + (size_t)e * D * DEXP, D, DEXP, WGU + (size_t)e * 1024 * D, p_norm_ffn_g, scr, r, F.lane); continue; } r -= I_G;
            transpose_item<0>(p_w_down + (size_t)e * DEXP * D, DEXP, D, WD + (size_t)e * D * DEXP, nullptr, scr, r, F.lane); }
    }
    SEAM(4);
    if (IN(5)) { DenseSched S; S.init(ACT1, Wout_t, D, D, T, D, F.G, (int)blockIdx.x); EpiRes E{p_x, X1, ACT0, ssq1};
        pg8::gemm_phase<EpiRes, DenseSched, false, false, SLOW>(F.lds, D, D, D, S, E); }
    SEAM(5);
    if (IN(6)) { DenseSched S; S.init(ACT0, Wq_t, D, D, T, D, F.G, (int)blockIdx.x); EpiBf16 E{ACT1, D, ssq1, QSCALE};
        pg8::gemm_phase<EpiBf16, DenseSched, false, false, SLOW>(F.lds, D, D, D, S, E); }
    SEAM(6);
    if (IN(7)) { AttnSched<0> S{(const char*)ACT1, (const char*)KB, (int)blockIdx.x}; EpiSoftmax E{ACT0};
        pg8::gemm_phase<EpiSoftmax, AttnSched<0>, false, false, SLOW>(F.lds, D, D, 256, S, E); }
    SEAM(7);
    if (IN(8)) { AttnSched<1> S{(const char*)ACT0, (const char*)VT, (int)blockIdx.x}; EpiBf16 E{ACT1, D, nullptr, 1.f};
        pg8::gemm_phase<EpiBf16, AttnSched<1>, false, false, SLOW>(F.lds, D, MEML, 256, S, E); }
    SEAM(8);
    if (IN(9)) { DenseSched S; S.init(ACT1, Wo_t, D, D, T, D, F.G, (int)blockIdx.x); EpiRes E{X1, X1, ACT0, ssq2};
        pg8::gemm_phase<EpiRes, DenseSched, false, false, SLOW>(F.lds, D, D, D, S, E); }
    SEAM(9);
    if (IN(10)) {
        LAS float* sl = (LAS float*)(F.lds + F.wave * 4096);
        for (int it = gw; it < T / 16; it += NGW) { const int t0 = it * 16, row = F.lane & 15, q = F.lane >> 4;
            f32x4 acc0 = {0.f, 0.f, 0.f, 0.f}, acc1 = acc0, acc2 = acc0;
            const float* xr = X1 + (size_t)(t0 + row) * D + 4 * q;
            for (int j = 0; j < 64; ++j) { const f32x4 a = *(const f32x4*)(xr + 16 * j);
#pragma unroll
                for (int i = 0; i < 4; ++i) { const float* wp = WR + (size_t)(16 * j + 4 * q + i) * 48 + row;
                    acc0 = __builtin_amdgcn_mfma_f32_16x16x4f32(a[i], wp[0], acc0, 0, 0, 0); acc1 = __builtin_amdgcn_mfma_f32_16x16x4f32(a[i], wp[16], acc1, 0, 0, 0); acc2 = __builtin_amdgcn_mfma_f32_16x16x4f32(a[i], wp[32], acc2, 0, 0, 0); } }
#pragma unroll
            for (int r = 0; r < 4; ++r) { sl[(4 * q + r) * 52 + row] = acc0[r]; sl[(4 * q + r) * 52 + 16 + row] = acc1[r]; sl[(4 * q + r) * 52 + 32 + row] = acc2[r]; }
            LDS_WAIT(); __builtin_amdgcn_wave_barrier();
            if (F.lane < 16) { const int t = t0 + F.lane; LAS float* L = sl + F.lane * 52;
                const float rs = rsqrtf(((ssq2[t] + ssq2[T + t]) + (ssq2[2 * T + t] + ssq2[3 * T + t])) * (1.f / D) + EPS);
                float gm = -1e30f; int gi = 0;
                for (int j = 0; j < 4; ++j) { const float v = L[j] * rs + p_b_rg[j]; if (v > gm) { gm = v; gi = j; } }
                float gs = 0.f; for (int j = 0; j < 4; ++j) gs += __expf(L[j] * rs + p_b_rg[j] - gm);
                const float gwt = 1.f / gs;
                float em = -1e30f;
                for (int j = 0; j < 8; ++j) { const float v = L[4 + gi * 8 + j] * rs + p_b_re[gi * 8 + j]; L[40 + j] = v; em = fmaxf(em, v); }
                float es = 0.f; for (int j = 0; j < 8; ++j) { const float p = __expf(L[40 + j] - em); L[40 + j] = p; es += p; }
                int i0 = 0; float p0 = L[40];
                for (int j = 1; j < 8; ++j) { const float p = L[40 + j]; if (p > p0) { p0 = p; i0 = j; } }
                int i1 = -1; float p1 = -1.f;
                for (int j = 0; j < 8; ++j) { const float p = L[40 + j]; if (j != i0 && p > p1) { p1 = p; i1 = j; } }
                p0 /= es; p1 /= es; const float ssum = p0 + p1; const int e0 = gi * 8 + i0, e1 = gi * 8 + i1;
                rstd2[t] = rs; tokg[t * 2] = gwt * p0 / ssum; tokg[t * 2 + 1] = gwt * p1 / ssum;
                const int q0 = atomicAdd(&CNT[e0], 1); LIST[e0 * T + q0] = t * 2;
                const int q1 = atomicAdd(&CNT[e1], 1); LIST[e1 * T + q1] = t * 2 + 1; }
            LDS_WAIT(); __builtin_amdgcn_wave_barrier(); }
    }
    SEAM(10);
    LAS int* tp = (LAS int*)(F.lds + MOE_TP_OFF); LAS int* lcnt = tp + 40; LAS int* lbase = tp + 80;
    if (IN(11) || IN(12)) {
        if (F.tid == 0) { int a = 0, bsum = 0; for (int e = 0; e < NEXP; ++e) { const int c = __hip_atomic_load((const int*)&CNT[e], RLX_AGENT); tp[e] = a; lcnt[e] = c; lbase[e] = bsum; a += (c + 255) >> 8; bsum += c; } tp[NEXP] = a; lbase[NEXP] = bsum; }
        LDS_WAIT(); __syncthreads();
    }
    if (IN(11)) { MoeSched<0> S{(const char*)ACT0, (const char*)WGU, LIST, tp, lcnt, lbase, F.G, (int)blockIdx.x}; EpiGU E{LIST, lcnt, rstd2, ACT1};
        pg8::gemm_phase<EpiGU, MoeSched<0>, true, true, SLOW>(F.lds, D, D, D, S, E); }
    SEAM(11);
    if (IN(12)) { MoeSched<1> S{(const char*)ACT1, (const char*)WD, LIST, tp, lcnt, lbase, F.G, (int)blockIdx.x}; EpiDown E{LIST, lcnt, tokg, ACT0, Y1};
        pg8::gemm_phase<EpiDown, MoeSched<1>, true, false, SLOW>(F.lds, DEXP, DEXP, DEXP, S, E); }
    SEAM(12);
    if (IN(13)) {
        for (int t = gw; t < T; t += NGW) { f32x4 v[4]; float s = 0.f;
#pragma unroll
            for (int j = 0; j < 4; ++j) { const size_t o = (size_t)t * D + 4 * F.lane + 256 * j; v[j] = *(const f32x4*)(X1 + o);
                const u32x2 a = *(const u32x2*)(ACT0 + o), b = *(const u32x2*)(Y1 + o);
                v[j][0] += __uint_as_float(a.x << 16) + __uint_as_float(b.x << 16); v[j][1] += __uint_as_float(a.x & 0xffff0000u) + __uint_as_float(b.x & 0xffff0000u);
                v[j][2] += __uint_as_float(a.y << 16) + __uint_as_float(b.y << 16); v[j][3] += __uint_as_float(a.y & 0xffff0000u) + __uint_as_float(b.y & 0xffff0000u);
                s += (v[j][0] * v[j][0] + v[j][1] * v[j][1]) + (v[j][2] * v[j][2] + v[j][3] * v[j][3]); }
            const float r = rsqrtf(wave_sum(s) * (1.f / D) + EPS);
#pragma unroll
            for (int j = 0; j < 4; ++j) { const int c = 4 * F.lane + 256 * j; const f32x4 g = *(const f32x4*)(p_final_g + c); *(f32x4*)(args.out + (size_t)t * D + c) = v[j] * r * g; } }
    }
#undef IN
#undef SEAM
}

constexpr int NPHASE = 14;
extern "C" void kernel_launch(void* const* d_in, const int* in_sizes, int n_in, void* d_out, int out_size, void* d_ws, size_t ws_size, hipStream_t stream) {
    static int grid = 0;
    if (grid == 0) {
        if (n_in != 22 || out_size != T * D || ws_size < WS_END) { fprintf(stderr, "kernel_launch: unexpected problem (n_in %d out %d ws %zu)\n", n_in, out_size, ws_size); grid = -1; return; }
        int dev = 0, cus = 0, per_cu = 0;
        if (hipGetDevice(&dev) != hipSuccess || hipDeviceGetAttribute(&cus, hipDeviceAttributeMultiprocessorCount, dev) != hipSuccess) { grid = -1; return; }
        if (hipFuncSetAttribute((const void*)mk_fwd, hipFuncAttributeMaxDynamicSharedMemorySize, LDS_BYTES) != hipSuccess) { fprintf(stderr, "kernel_launch: hipFuncSetAttribute failed\n"); grid = -1; return; }
        if (hipOccupancyMaxActiveBlocksPerMultiprocessor(&per_cu, (const void*)mk_fwd, NWAVES * 64, LDS_BYTES) != hipSuccess || per_cu < 1) { fprintf(stderr, "kernel_launch: occupancy query says %d\n", per_cu); per_cu = 1; }
        (void)hipGetLastError();
        grid = cus;
        if (grid != 256) fprintf(stderr, "kernel_launch: %d CUs (built for 256)\n", grid);
    }
    if (grid < 0) return;
    (void)hipMemsetAsync((char*)d_ws + WS_CTL, 0, CTL_ZERO_BYTES, stream);
    Args a{};
    for (int i = 0; i < 22; ++i) a.in[i] = (const float*)d_in[i];
    a.out = (float*)d_out; a.ws = (unsigned char*)d_ws; a.ph_lo = 0; a.ph_hi = NPHASE;
    hipLaunchKernelGGL(mk_fwd, dim3(grid), dim3(NWAVES * 64), LDS_BYTES, stream, a);
}
```

```cpp
#include <hip/hip_runtime.h>
#include <cstdint>
#include <cstdio>

#ifndef MK_FENCE_ALL
#define MK_FENCE_ALL 0
#endif
#ifndef MK_SLOW
#define MK_SLOW 0
#endif

#define LAS __attribute__((address_space(3)))
#define GAS __attribute__((address_space(1)))
typedef unsigned short bf16_t;
typedef short bf16x8 __attribute__((ext_vector_type(8)));
typedef float f32x4 __attribute__((ext_vector_type(4)));
typedef float f32x2 __attribute__((ext_vector_type(2)));
typedef unsigned u32x4 __attribute__((ext_vector_type(4)));
typedef unsigned u32x2 __attribute__((ext_vector_type(2)));
typedef GAS unsigned gu32;

constexpr int T = 16384, D = 1024, SEQ = 4096, NB = 4, MEML = 256, NEXP = 32, DEXP = 512, INCOLS = 2048;
constexpr float EPS = 1e-6f;
constexpr float QSCALE = 0.0625f * 1.4426950408889634f;
constexpr int NWAVES = 8;

constexpr size_t MiB = 1u << 20;
constexpr size_t WS_CTL = 0, CTL_ZERO_BYTES = 1 * MiB;
constexpr size_t WS_WIN = 1 * MiB, WS_WOUT = 5 * MiB, WS_WQ = 7 * MiB, WS_WKV = 9 * MiB, WS_WO = 13 * MiB;
constexpr size_t WS_KB = 15 * MiB, WS_VT = 17 * MiB, WS_MB = 19 * MiB, WS_LIST = 21 * MiB, WS_MISC = 23 * MiB;
constexpr size_t MS_RSTD0 = 0, MS_RSTDM = 64 * 1024, MS_SSQ1 = 128 * 1024, MS_SSQ2 = 384 * 1024, MS_RSTD2 = 640 * 1024, MS_TOKG = 704 * 1024, MS_WR = 832 * 1024;
constexpr size_t WS_X1 = 24 * MiB;
constexpr size_t WS_UF = 24 * MiB, WS_YF = 40 * MiB;
constexpr size_t WS_ACT0 = 88 * MiB, WS_ACT1 = 120 * MiB;
constexpr size_t WS_WGU = 152 * MiB, WS_WD = 216 * MiB;
constexpr size_t WS_BG = 248 * MiB, WS_CV = 264 * MiB, WS_Y1 = 248 * MiB, WS_END = 280 * MiB;
constexpr int CW_BAR = 4096, CW_CNT = 16384;

constexpr int RING_BYTES = 131072, LDSCTL_OFF = RING_BYTES, MISC_OFF = LDSCTL_OFF + 320, LDS_BYTES = 147456;
constexpr int MOE_TP_OFF = LDSCTL_OFF + 1024;

#define RLX_AGENT __ATOMIC_RELAXED, __HIP_MEMORY_SCOPE_AGENT
#define LDS_WAIT() asm volatile("s_waitcnt lgkmcnt(0)" ::: "memory")
#define VM_WAIT() asm volatile("s_waitcnt vmcnt(0)" ::: "memory")
typedef __bf16 bf16x2_t __attribute__((ext_vector_type(2)));
__device__ __forceinline__ unsigned cvt_pk_bf16(float lo, float hi) { const f32x2 v = {lo, hi}; const bf16x2_t b = __builtin_convertvector(v, bf16x2_t); return __builtin_bit_cast(unsigned, b); }
__device__ __forceinline__ u32x2 pk4(f32x4 v) { u32x2 w; w.x = cvt_pk_bf16(v[0], v[1]); w.y = cvt_pk_bf16(v[2], v[3]); return w; }
__device__ __forceinline__ float bf2f(unsigned short h) { return __uint_as_float((unsigned)h << 16); }
__device__ __forceinline__ float wave_sum(float v) {
#pragma unroll
    for (int o = 1; o < 64; o <<= 1) v += __shfl_xor(v, o);
    return v;
}

#define XB_TMO      128
#define XB_XCNT(j)  (256  + 64 * (j))
#define XB_XSUB(j)  (1280 + 64 * (j))
#define XB_XGEN(j)  (2304 + 64 * (j))
#define XB_TOP      3328
#define XB_TOPGEN   3392
#define XCD_BAR_WORDS 3456
#define XB_SPIN_CAP (1u << 18)
__device__ __forceinline__ unsigned xb_ld(unsigned* p)              { return __hip_atomic_load(p, __ATOMIC_RELAXED, __HIP_MEMORY_SCOPE_AGENT); }
__device__ __forceinline__ unsigned xb_add(unsigned* p, unsigned v) { return __hip_atomic_fetch_add(p, v, __ATOMIC_RELAXED, __HIP_MEMORY_SCOPE_AGENT); }
__device__ __forceinline__ unsigned xb_xcc_id() { return (unsigned)__builtin_amdgcn_s_getreg((3 << 11) | 20) & 0xFu; }
#define XB_SPIN(cond, bar) do { unsigned _sp = 0; while (cond) { __builtin_amdgcn_s_sleep(1); \
    if ((++_sp & 255u) == 0u) { if (xb_ld(&(bar)[XB_TMO])) break; if (_sp > XB_SPIN_CAP) { atomicAdd(&(bar)[XB_TMO], 1u); break; } } } } while (0)
struct XcdBarrier { unsigned* bar; unsigned x; volatile LAS unsigned* st; };
__device__ __forceinline__ XcdBarrier xcd_barrier_post(unsigned* bar, volatile LAS unsigned* st) {
    XcdBarrier b; b.bar = bar; b.x = xb_xcc_id(); b.st = st;
    if (threadIdx.x == 0) (void)xb_add(&bar[XB_XCNT(b.x)], 1u);
    return b;
}
__device__ __forceinline__ void xcd_barrier_complete(unsigned* bar, unsigned x, unsigned& nloc, unsigned& nx) {
    const unsigned G = gridDim.x * gridDim.y * gridDim.z;
    unsigned sum, cnt, mine, sp = 0u;
    for (;;) {
        sum = 0u; cnt = 0u; mine = 0u;
#pragma unroll
        for (unsigned j = 0; j < 16; ++j) { const unsigned c = xb_ld(&bar[XB_XCNT(j)]); sum += c; cnt += (c > 0u) ? 1u : 0u; mine = (j == x) ? c : mine; }
        if (sum == G) break;
        __builtin_amdgcn_s_sleep(1);
        if ((++sp & 255u) == 0u) { if (xb_ld(&bar[XB_TMO])) break; if (sp > XB_SPIN_CAP) { atomicAdd(&bar[XB_TMO], 1u); break; } }
    }
    nloc = mine > 0u ? mine : 1u; nx = cnt > 0u ? cnt : 1u;
}
__device__ __forceinline__ void xcd_barrier(const XcdBarrier& b) {
    asm volatile("s_waitcnt vmcnt(0)" ::: "memory");
#if MK_FENCE_ALL
    __threadfence(); asm volatile("s_waitcnt vmcnt(0)" ::: "memory");
#endif
    __syncthreads();
    if (threadIdx.x == 0) {
        unsigned* bar = b.bar;
        __builtin_amdgcn_s_waitcnt(0);
        unsigned nloc = b.st[0], nx = b.st[1];
        if (nloc == 0u) { xcd_barrier_complete(bar, b.x, nloc, nx); b.st[0] = nloc; b.st[1] = nx; }
        const unsigned old = xb_add(&bar[XB_XSUB(b.x)], 1u);
        const unsigned gen = old / nloc;
        if (old + 1u == (gen + 1u) * nloc) {
            __builtin_amdgcn_fence(__ATOMIC_RELEASE, "agent");
            asm volatile("s_waitcnt vmcnt(0)" ::: "memory");
            const unsigned og = xb_add(&bar[XB_TOP], 1u);
            const unsigned tg = og / nx;
            if (og + 1u == (tg + 1u) * nx) xb_add(&bar[XB_TOPGEN], 1u);
            else XB_SPIN(xb_ld(&bar[XB_TOPGEN]) == tg, bar);
            __builtin_amdgcn_fence(__ATOMIC_ACQUIRE, "agent");
            xb_add(&bar[XB_XGEN(b.x)], 1u);
            asm volatile("s_waitcnt vmcnt(0)" ::: "memory");
        } else {
            XB_SPIN(xb_ld(&bar[XB_XGEN(b.x)]) == gen, bar);
            __builtin_amdgcn_fence(__ATOMIC_ACQUIRE, "agent");
            asm volatile("s_waitcnt vmcnt(0)" ::: "memory");
        }
    }
    __syncthreads();
#if MK_FENCE_ALL
    __threadfence(); asm volatile("s_waitcnt vmcnt(0)" ::: "memory"); __syncthreads();
#endif
}

namespace pg8 {
constexpr int BM = 256, BK = 64, HALF = 128, HTB = HALF * BK * 2, STAGE_BYTES = 8 * HTB;
__host__ __device__ __forceinline__ int lds_byte(int r, int c) { const int st = (r >> 4) * 2 + (c >> 5), rr = r & 15, cc = c & 31, ob = rr * 64 + cc * 2; return st * 1024 + (ob ^ (((ob >> 9) & 1) << 5)); }
__host__ __device__ __forceinline__ void stage_rc(int b, int& R, int& C) { const int st = b / 1024, sb = b % 1024, swz = sb ^ (((sb >> 9) & 1) << 5); R = (st >> 1) * 16 + swz / 64; C = (st & 1) * 32 + (swz % 64) / 2; }

struct Unit { const char* a; const char* b; int crow, ccol, z, e; };

typedef f32x4 Acc[2][2][4][2];

template <class Epi, class Sched, bool ALIGN_EPI, bool GATHER, bool SLOW>
__device__ __forceinline__ void gemm_phase(LAS unsigned char* lds, const int lda, const int ldb, const int K, const Sched& S, const Epi& E) {
    const int tid = threadIdx.x, wid = __builtin_amdgcn_readfirstlane(tid >> 6), lane = tid & 63, wr = wid >> 2, wc = wid & 3, fr = lane & 15, fq = lane >> 4;
    Unit cur, nxt; int ui = 0;
    if (!S.next(0, cur)) return;
    Acc acc;
#define PG8_ZERO() do { _Pragma("unroll") for (int a_ = 0; a_ < 2; ++a_) _Pragma("unroll") for (int b_ = 0; b_ < 2; ++b_) _Pragma("unroll") for (int m_ = 0; m_ < 4; ++m_) _Pragma("unroll") for (int n_ = 0; n_ < 2; ++n_) acc[a_][b_][m_][n_] = (f32x4){0.f, 0.f, 0.f, 0.f}; } while (0)
    if constexpr (SLOW) {
        for (;;) {
            PG8_ZERO();
            unsigned ao[2][4], bo[2][2];
#pragma unroll
            for (int ai = 0; ai < 2; ++ai)
#pragma unroll
                for (int m = 0; m < 4; ++m) { const int row = ai * 128 + wr * 64 + m * 16 + fr; ao[ai][m] = (unsigned)(GATHER ? S.gather_row(cur, row) : row) * (unsigned)lda * 2u + (unsigned)fq * 16u; }
#pragma unroll
            for (int bj = 0; bj < 2; ++bj)
#pragma unroll
                for (int n = 0; n < 2; ++n) bo[bj][n] = (unsigned)(bj * 128 + wc * 32 + n * 16 + fr) * (unsigned)ldb * 2u + (unsigned)fq * 16u;
#pragma unroll 1
            for (int k0 = 0; k0 < K; k0 += 32) {
                bf16x8 af[2][4], bfr[2][2];
#pragma unroll
                for (int ai = 0; ai < 2; ++ai)
#pragma unroll
                    for (int m = 0; m < 4; ++m) af[ai][m] = *(const bf16x8*)(cur.a + ao[ai][m] + (size_t)k0 * 2);
#pragma unroll
                for (int bj = 0; bj < 2; ++bj)
#pragma unroll
                    for (int n = 0; n < 2; ++n) bfr[bj][n] = *(const bf16x8*)(cur.b + bo[bj][n] + (size_t)k0 * 2);
#pragma unroll
                for (int ai = 0; ai < 2; ++ai)
#pragma unroll
                    for (int bj = 0; bj < 2; ++bj)
#pragma unroll
                        for (int m = 0; m < 4; ++m)
#pragma unroll
                            for (int n = 0; n < 2; ++n) acc[ai][bj][m][n] = __builtin_amdgcn_mfma_f32_16x16x32_bf16(bfr[bj][n], af[ai][m], acc[ai][bj][m][n], 0, 0, 0);
            }
            if constexpr (!Epi::AFTER_DRAIN) { E(acc, cur, wr, wc, fr, fq); }
            else { __syncthreads(); E.fused(acc, cur, wr, wc, fr, fq, lds, wid, lane); __syncthreads(); }
            ++ui; if (!S.next(ui, cur)) break;
        }
        return;
    } else {
    const int nt = K / BK;
    unsigned voffA[2], voffB[2], voffC[2];
#pragma unroll
    for (int i = 0; i < 2; ++i) { int R, C; stage_rc(tid * 16 + i * 8192, R, C); voffA[i] = (unsigned)(R * lda + C) * 2u; voffB[i] = (unsigned)(R * ldb + C) * 2u; voffC[i] = (unsigned)C * 2u; }
    const unsigned hstepA = (unsigned)HALF * (unsigned)lda * 2u, hstepB = (unsigned)HALF * (unsigned)ldb * 2u;
    const size_t kstep = (size_t)(BK * 2);
    const unsigned ldsw = (unsigned)wid * 1024u;
    const int aoff = lds_byte(wr * 64 + fr, fq * 8), boff = lds_byte(wc * 32 + fr, fq * 8);
    unsigned vg[2][2];
#define PG8_GROWS(vg, u) do { _Pragma("unroll") for (int h_ = 0; h_ < 2; ++h_) _Pragma("unroll") for (int i_ = 0; i_ < 2; ++i_) { int R_, C_; stage_rc(tid * 16 + i_ * 8192, R_, C_); \
        vg[h_][i_] = (unsigned)S.gather_row(u, h_ * HALF + R_) * (unsigned)lda * 2u + voffC[i_]; } } while (0)
#define PG8_SA(b, h) (((b) * 2 + (h)) * HTB)
#define PG8_SB(b, h) ((4 + (b) * 2 + (h)) * HTB)
#define PG8_GLDS(src, dstoff) __builtin_amdgcn_global_load_lds((const unsigned*)(src), (LAS unsigned*)(lds + (dstoff)), 16, 0, 0)
#define PG8_STAGE_B(bufoff, gbase) do { _Pragma("unroll") for (int _i = 0; _i < 2; ++_i) PG8_GLDS((const char*)(gbase) + voffB[_i], (bufoff) + ldsw + _i * 8192); } while (0)
#define PG8_STAGE_A(bufoff, kptr, h, nx) do { _Pragma("unroll") for (int _i = 0; _i < 2; ++_i) { \
        const unsigned vo_ = GATHER ? vg[h][_i] : (voffA[_i] + (unsigned)(h) * hstepA); PG8_GLDS((const char*)(kptr) + vo_, (bufoff) + ldsw + _i * 8192); } } while (0)
#define PG8_LDA(dst, b, h) do { _Pragma("unroll") for (int m = 0; m < 4; ++m) _Pragma("unroll") for (int k = 0; k < 2; ++k) dst[m][k] = *(const LAS bf16x8*)(lds + PG8_SA(b, h) + aoff + m * 2048 + k * 1024); } while (0)
#define PG8_LDB(dst, b, h) do { _Pragma("unroll") for (int n = 0; n < 2; ++n) _Pragma("unroll") for (int k = 0; k < 2; ++k) dst[n][k] = *(const LAS bf16x8*)(lds + PG8_SB(b, h) + boff + n * 2048 + k * 1024); } while (0)
#define PG8_MMA(ai, bj, At, Bt) do { __builtin_amdgcn_s_setprio(1); _Pragma("unroll") for (int m = 0; m < 4; ++m) _Pragma("unroll") for (int n = 0; n < 2; ++n) _Pragma("unroll") for (int k = 0; k < 2; ++k) \
        acc[ai][bj][m][n] = __builtin_amdgcn_mfma_f32_16x16x32_bf16(Bt[n][k], At[m][k], acc[ai][bj][m][n], 0, 0, 0); __builtin_amdgcn_s_setprio(0); } while (0)
#define PG8_WAIT_V(n) asm volatile("s_waitcnt vmcnt(" #n ")" ::: "memory")
#define PG8_WAIT_L(n) asm volatile("s_waitcnt lgkmcnt(" #n ")" ::: "memory")
#define PG8_BAR __builtin_amdgcn_s_barrier()
#define PG8_SCHED __builtin_amdgcn_sched_barrier(0)
    PG8_ZERO();
    bf16x8 At[4][2], B0[2][2], B1[2][2];
    const char* cA = cur.a; const char* cB = cur.b;
    if constexpr (GATHER) { PG8_GROWS(vg, cur); }
    PG8_STAGE_B(PG8_SB(0, 0), cB); PG8_STAGE_B(PG8_SB(0, 1), cB + hstepB); PG8_STAGE_A(PG8_SA(0, 0), cA, 0, false); PG8_STAGE_A(PG8_SA(0, 1), cA, 1, false);
    if (wr == 1) PG8_BAR;
    PG8_WAIT_V(2); PG8_BAR;
    PG8_STAGE_B(PG8_SB(1, 0), cB + kstep); PG8_STAGE_A(PG8_SA(1, 0), cA + kstep, 0, false); PG8_STAGE_B(PG8_SB(1, 1), cB + hstepB + kstep);
    PG8_WAIT_V(6); PG8_BAR;
    for (;;) {
        const bool has_next = S.next(ui + 1, nxt);
        const char* nA = has_next ? nxt.a : cA; const char* nB = has_next ? nxt.b : cB;
        for (int t = 0; t < nt; t += 2) {
            const bool last = (t == nt - 2);
            const char* a1 = cA + (size_t)(t + 1) * kstep;
            const char* a2 = last ? nA : cA + (size_t)(t + 2) * kstep; const char* b2 = last ? nB : cB + (size_t)(t + 2) * kstep;
            const char* a3 = a2 + kstep; const char* b3 = b2 + kstep;
            PG8_LDB(B0, 0, 0); PG8_LDB(B1, 0, 1); PG8_SCHED; PG8_LDA(At, 0, 0); PG8_STAGE_A(PG8_SA(1, 1), a1, 1, false);
            if constexpr (GATHER) { if (last && has_next) { PG8_GROWS(vg, nxt); } }
            PG8_WAIT_V(8); PG8_WAIT_L(0); PG8_BAR; PG8_MMA(0, 0, At, B0); PG8_MMA(0, 1, At, B1); PG8_BAR; PG8_SCHED;
            PG8_LDA(At, 0, 1); PG8_STAGE_B(PG8_SB(0, 0), b2); PG8_STAGE_B(PG8_SB(0, 1), b2 + hstepB); PG8_STAGE_A(PG8_SA(0, 0), a2, 0, last);
            PG8_WAIT_V(8); PG8_WAIT_L(0); PG8_BAR; PG8_MMA(1, 0, At, B0); PG8_MMA(1, 1, At, B1); PG8_BAR; PG8_SCHED;
            PG8_LDB(B0, 1, 0); PG8_LDB(B1, 1, 1); PG8_SCHED; PG8_LDA(At, 1, 0); PG8_STAGE_A(PG8_SA(0, 1), a2, 1, last);
            PG8_WAIT_V(8); PG8_WAIT_L(0); PG8_BAR; PG8_MMA(0, 0, At, B0); PG8_MMA(0, 1, At, B1); PG8_BAR; PG8_SCHED;
            PG8_LDA(At, 1, 1); PG8_STAGE_B(PG8_SB(1, 0), b3); PG8_STAGE_B(PG8_SB(1, 1), b3 + hstepB); PG8_STAGE_A(PG8_SA(1, 0), a3, 0, last);
            PG8_WAIT_V(8); PG8_WAIT_L(0); PG8_BAR; PG8_MMA(1, 0, At, B0); PG8_MMA(1, 1, At, B1); PG8_BAR; PG8_SCHED;
        }
        if constexpr (ALIGN_EPI) { if (wr == 0) PG8_BAR; }
        if constexpr (!Epi::AFTER_DRAIN) { E(acc, cur, wr, wc, fr, fq); }
        if (!has_next) break;
        PG8_WAIT_V(0);
        PG8_ZERO();
        cur = nxt; cA = nA; cB = nB; ++ui;
        if constexpr (ALIGN_EPI) { if (wr == 1) PG8_BAR; }
    }
    PG8_WAIT_V(0);
    if constexpr (!ALIGN_EPI) { if (wr == 0) PG8_BAR; }
    PG8_BAR;
    if constexpr (Epi::AFTER_DRAIN) { E.fused(acc, cur, wr, wc, fr, fq, lds, wid, lane); }
#undef PG8_SA
#undef PG8_SB
#undef PG8_GLDS
#undef PG8_STAGE_A
#undef PG8_STAGE_B
#undef PG8_LDA
#undef PG8_LDB
#undef PG8_MMA
#undef PG8_WAIT_V
#undef PG8_WAIT_L
#undef PG8_BAR
#undef PG8_SCHED
#undef PG8_GROWS
    }
#undef PG8_ZERO
}
}
using pg8::Unit; using pg8::Acc;

struct DenseSched {
    const char* A; const char* Bt; int lda, ldb, nM, nN, nwg, G, c;
    __device__ __forceinline__ void init(const void* A_, const void* Bt_, int lda_, int ldb_, int M, int N, int G_, int c_) { A = (const char*)A_; Bt = (const char*)Bt_; lda = lda_; ldb = ldb_; nM = M / 256; nN = N / 256; nwg = nM * nN; G = G_; c = c_; }
    __device__ __forceinline__ bool next(int i, Unit& u) const {
        const long L = (long)i * G + c; if (L >= nwg) return false;
        int wgid = (int)L; { const int q = nwg / 8, r = nwg % 8, xcd = wgid % 8, off = wgid / 8; wgid = (xcd < r ? xcd * (q + 1) : r * (q + 1) + (xcd - r) * q) + off; }
        const int nig = 8 * nN, gid = wgid / nig, fm = gid * 8, gsz = (nM - fm) < 8 ? (nM - fm) : 8;
        const int pm = fm + ((wgid % nig) % gsz), pn = (wgid % nig) / gsz;
        u.a = A + (size_t)pm * 256 * lda * 2; u.b = Bt + (size_t)pn * 256 * ldb * 2; u.crow = pm * 256; u.ccol = pn * 256; u.z = pn; u.e = 0; return true;
    }
    __device__ __forceinline__ int gather_row(const Unit&, int r) const { return r; }
};
template <int MODE> struct AttnSched {
    const char* A; const char* B; int c;
    __device__ __forceinline__ bool next(int i, Unit& u) const {
        if (i > 0 || c >= 256) return false;
        const int vc = (c & 7) * 32 + (c >> 3);
        const int bh = vc >> 4, pm = vc & 15, b = bh >> 2, h = bh & 3;
        u.a = A + ((size_t)(b * SEQ + pm * 256) * D + h * 256) * 2;
        u.b = MODE == 0 ? B + ((size_t)(b * MEML) * D + h * 256) * 2 : B + ((size_t)(b * D + h * 256) * MEML) * 2;
        u.crow = b * SEQ + pm * 256; u.ccol = h * 256; u.z = bh; u.e = 0; return true;
    }
    __device__ __forceinline__ int gather_row(const Unit&, int r) const { return r; }
};
template <int MODE  > struct MoeSched {
    const char* A; const char* Bw; const int* list; const LAS int* tp; const LAS int* cnt; const LAS int* base; int G, c;
    __device__ __forceinline__ bool next(int i, Unit& u) const {
        const int L = i * G + c; const int tile = L >> 2, pn = L & 3;
        if (tile >= tp[NEXP]) return false;
        int e = 0;
        for (int j = 1; j < NEXP; ++j) e += (tp[j] <= tile) ? 1 : 0;
        const int mt = tile - tp[e];
        u.e = e; u.z = mt; u.crow = base[e] + mt * 256; u.ccol = pn * 256;
        if (MODE == 0) { u.a = A; u.b = Bw + ((size_t)e * 1024 + pn * 256) * D * 2; }
        else { u.a = A + (size_t)(base[e] + mt * 256) * DEXP * 2; u.b = Bw + ((size_t)e * D + pn * 256) * DEXP * 2; }
        return true;
    }
    __device__ __forceinline__ int gather_row(const Unit& u, int r) const {
        const int p = u.z * 256 + r; return p < cnt[u.e] ? (list[u.e * T + p] >> 1) : 0;
    }
};

#define EPI_ROW(ai, m) ((ai) * 128 + wr * 64 + (m) * 16 + fr)
#define EPI_COL(bj, n) ((bj) * 128 + wc * 32 + (n) * 16 + 4 * fq)
struct EpiMix {
    static constexpr bool AFTER_DRAIN = false;
    const float* rstd0; bf16_t* bg; bf16_t* cv; bf16_t* uf;
    __device__ __forceinline__ void operator()(const Acc& acc, const Unit& u, int wr, int wc, int fr, int fq) const {
        const int ch = u.z * 64 + wc * 16 + 4 * fq;
#pragma unroll
        for (int ai = 0; ai < 2; ++ai)
#pragma unroll
            for (int m = 0; m < 4; ++m) { const int row = u.crow + EPI_ROW(ai, m); const float r = rstd0[row];
                const f32x4 b = acc[ai][0][m][0] * r, c = acc[ai][0][m][1] * r, v = acc[ai][1][m][0] * r, f = acc[ai][1][m][1] * r;
                const size_t o = (size_t)row * 512 + ch;
                *(u32x2*)(bg + o) = pk4(b); *(u32x2*)(cv + o) = pk4(c * v); *(u32x2*)(uf + o) = pk4(f); }
    }
};
struct EpiKV {
    static constexpr bool AFTER_DRAIN = false;
    const float* rstdm; bf16_t* kb; bf16_t* vt;
    __device__ __forceinline__ void operator()(const Acc& acc, const Unit& u, int wr, int wc, int fr, int fq) const {
#pragma unroll
        for (int ai = 0; ai < 2; ++ai)
#pragma unroll
            for (int m = 0; m < 4; ++m) { const int row = u.crow + EPI_ROW(ai, m); const float r = rstdm[row];
#pragma unroll
                for (int bj = 0; bj < 2; ++bj)
#pragma unroll
                    for (int n = 0; n < 2; ++n) { const int col = u.ccol + EPI_COL(bj, n); const f32x4 v = acc[ai][bj][m][n] * r;
                        if (col < D) *(u32x2*)(kb + (size_t)row * D + col) = pk4(v);
                        else { const int b = row >> 8, key = row & 255; const u32x2 w = pk4(v); bf16_t* p = vt + ((size_t)b * D + (col - D)) * MEML + key;
                            p[0] = (bf16_t)(w.x & 0xffffu); p[MEML] = (bf16_t)(w.x >> 16); p[2 * MEML] = (bf16_t)(w.y & 0xffffu); p[3 * MEML] = (bf16_t)(w.y >> 16); } } }
    }
};
struct EpiF32 {
    static constexpr bool AFTER_DRAIN = false;
    float* C; int ldc;
    __device__ __forceinline__ void operator()(const Acc& acc, const Unit& u, int wr, int wc, int fr, int fq) const {
#pragma unroll
        for (int ai = 0; ai < 2; ++ai)
#pragma unroll
            for (int m = 0; m < 4; ++m) { float* rowp = C + (size_t)(u.crow + EPI_ROW(ai, m)) * ldc + u.ccol;
#pragma unroll
                for (int bj = 0; bj < 2; ++bj)
#pragma unroll
                    for (int n = 0; n < 2; ++n) *(f32x4*)(rowp + EPI_COL(bj, n)) = acc[ai][bj][m][n]; }
    }
};
struct EpiBf16 {
    static constexpr bool AFTER_DRAIN = false;
    bf16_t* O; int ldc; const float* ssq; float cs;
    __device__ __forceinline__ void operator()(const Acc& acc, const Unit& u, int wr, int wc, int fr, int fq) const {
#pragma unroll
        for (int ai = 0; ai < 2; ++ai)
#pragma unroll
            for (int m = 0; m < 4; ++m) { const int row = u.crow + EPI_ROW(ai, m); float r = cs;
                if (ssq) r *= rsqrtf(((ssq[row] + ssq[T + row]) + (ssq[2 * T + row] + ssq[3 * T + row])) * (1.f / D) + EPS);
                bf16_t* rowp = O + (size_t)row * ldc + u.ccol;
#pragma unroll
                for (int bj = 0; bj < 2; ++bj)
#pragma unroll
                    for (int n = 0; n < 2; ++n) *(u32x2*)(rowp + EPI_COL(bj, n)) = pk4(acc[ai][bj][m][n] * r); }
    }
};
struct EpiRes {
    static constexpr bool AFTER_DRAIN = true;
    const float* xin; float* xo; bf16_t* xb; float* ssq;
    __device__ __forceinline__ void fused(Acc& acc, const Unit& u, int wr, int wc, int fr, int fq, LAS unsigned char* lds, int wid, int lane) const {
        LAS float* P = (LAS float*)lds;
#pragma unroll
        for (int ai = 0; ai < 2; ++ai)
#pragma unroll
            for (int m = 0; m < 4; ++m) { const int rl = EPI_ROW(ai, m); const size_t ro = (size_t)(u.crow + rl) * D + u.ccol; float s = 0.f;
#pragma unroll
                for (int bj = 0; bj < 2; ++bj)
#pragma unroll
                    for (int n = 0; n < 2; ++n) { const size_t o = ro + EPI_COL(bj, n); const f32x4 v = *(const f32x4*)(xin + o) + acc[ai][bj][m][n];
                        *(f32x4*)(xo + o) = v; *(u32x2*)(xb + o) = pk4(v); s += (v[0] * v[0] + v[1] * v[1]) + (v[2] * v[2] + v[3] * v[3]); }
                s += __shfl_xor(s, 16); s += __shfl_xor(s, 32);
                if (fq == 0) P[rl * 4 + wc] = s; }
        LDS_WAIT(); __syncthreads();
        const int tid = wid * 64 + lane;
        if (tid < 256) ssq[(size_t)u.z * T + u.crow + tid] = (P[tid * 4 + 0] + P[tid * 4 + 1]) + (P[tid * 4 + 2] + P[tid * 4 + 3]);
        LDS_WAIT(); __syncthreads();
    }
};
struct EpiSoftmax {
    static constexpr bool AFTER_DRAIN = true;
    bf16_t* Pm;
    __device__ __forceinline__ void fused(Acc& acc, const Unit& u, int wr, int wc, int fr, int fq, LAS unsigned char* lds, int wid, int lane) const {
        LAS float* PM = (LAS float*)lds; LAS float* PS = (LAS float*)(lds + 4096);
#pragma unroll
        for (int ai = 0; ai < 2; ++ai)
#pragma unroll
            for (int m = 0; m < 4; ++m) { float mx = -1e30f;
#pragma unroll
                for (int bj = 0; bj < 2; ++bj)
#pragma unroll
                    for (int n = 0; n < 2; ++n) { const f32x4 v = acc[ai][bj][m][n]; mx = fmaxf(mx, fmaxf(fmaxf(v[0], v[1]), fmaxf(v[2], v[3]))); }
                mx = fmaxf(mx, __shfl_xor(mx, 16)); mx = fmaxf(mx, __shfl_xor(mx, 32));
                if (fq == 0) PM[EPI_ROW(ai, m) * 4 + wc] = mx; }
        LDS_WAIT(); __syncthreads();
#pragma unroll
        for (int ai = 0; ai < 2; ++ai)
#pragma unroll
            for (int m = 0; m < 4; ++m) { const int rl = EPI_ROW(ai, m); const float mx = fmaxf(fmaxf(PM[rl * 4], PM[rl * 4 + 1]), fmaxf(PM[rl * 4 + 2], PM[rl * 4 + 3])); float s = 0.f;
#pragma unroll
                for (int bj = 0; bj < 2; ++bj)
#pragma unroll
                    for (int n = 0; n < 2; ++n) { f32x4 v = acc[ai][bj][m][n];
#pragma unroll
                        for (int i = 0; i < 4; ++i) { v[i] = __builtin_amdgcn_exp2f(v[i] - mx); s += v[i]; }
                        acc[ai][bj][m][n] = v; }
                s += __shfl_xor(s, 16); s += __shfl_xor(s, 32);
                if (fq == 0) PS[rl * 4 + wc] = s; }
        LDS_WAIT(); __syncthreads();
#pragma unroll
        for (int ai = 0; ai < 2; ++ai)
#pragma unroll
            for (int m = 0; m < 4; ++m) { const int rl = EPI_ROW(ai, m); const float inv = 1.f / ((PS[rl * 4] + PS[rl * 4 + 1]) + (PS[rl * 4 + 2] + PS[rl * 4 + 3]));
                bf16_t* rowp = Pm + (size_t)(u.crow + rl) * D + u.ccol;
#pragma unroll
                for (int bj = 0; bj < 2; ++bj)
#pragma unroll
                    for (int n = 0; n < 2; ++n) *(u32x2*)(rowp + EPI_COL(bj, n)) = pk4(acc[ai][bj][m][n] * inv); }
        LDS_WAIT(); __syncthreads();
    }
};
struct EpiGU {
    static constexpr bool AFTER_DRAIN = false;
    const int* list; const LAS int* cnt; const float* rstd2; bf16_t* hmid;
    __device__ __forceinline__ void operator()(const Acc& acc, const Unit& u, int wr, int wc, int fr, int fq) const {
        const int pn = u.ccol >> 8;
#pragma unroll
        for (int ai = 0; ai < 2; ++ai)
#pragma unroll
            for (int m = 0; m < 4; ++m) { const int rl = EPI_ROW(ai, m), p = u.z * 256 + rl;
                if (p < cnt[u.e]) { const int tok = list[u.e * T + p] >> 1; const float r = rstd2[tok];
#pragma unroll
                    for (int bj = 0; bj < 2; ++bj) { const f32x4 a = acc[ai][bj][m][0] * r, b = acc[ai][bj][m][1] * r; f32x4 h;
#pragma unroll
                        for (int i = 0; i < 4; ++i) h[i] = a[i] / (1.f + __expf(-a[i])) * b[i];
                        *(u32x2*)(hmid + (size_t)(u.crow + rl) * DEXP + pn * 128 + bj * 64 + wc * 16 + 4 * fq) = pk4(h); } } }
    }
};
struct EpiDown {
    static constexpr bool AFTER_DRAIN = false;
    const int* list; const LAS int* cnt; const float* tokg; bf16_t* y0; bf16_t* y1;
    __device__ __forceinline__ void operator()(const Acc& acc, const Unit& u, int wr, int wc, int fr, int fq) const {
#pragma unroll
        for (int ai = 0; ai < 2; ++ai)
#pragma unroll
            for (int m = 0; m < 4; ++m) { const int rl = EPI_ROW(ai, m), p = u.z * 256 + rl;
                if (p < cnt[u.e]) { const int ent = list[u.e * T + p]; const float g = tokg[ent]; bf16_t* rowp = ((ent & 1) ? y1 : y0) + (size_t)(ent >> 1) * D + u.ccol;
#pragma unroll
                    for (int bj = 0; bj < 2; ++bj)
#pragma unroll
                        for (int n = 0; n < 2; ++n) *(u32x2*)(rowp + EPI_COL(bj, n)) = pk4(acc[ai][bj][m][n] * g); } }
    }
};

struct Args { const float* in[22]; float* out; unsigned char* ws; int ph_lo, ph_hi; };
struct Frame { LAS unsigned char* lds; volatile LAS unsigned* MISC; gu32* ctl; int tid, lane, wave, vcu, G; };

template <int MAP> __device__ __forceinline__ int dest_row(int n) {
    if (MAP == 0) return n;
    if (MAP == 1) { const int sec = n < 1536 ? n / 512 : 3, within = n < 1536 ? n % 512 : n - 1536, pn = within >> 6, ch = within & 63;
        return pn * 256 + 128 * (sec >> 1) + 32 * (ch >> 4) + 16 * (sec & 1) + (ch & 15); }
    const int pn = n >> 7, bj = (n >> 6) & 1, wc = (n >> 4) & 3; return pn * 256 + 128 * bj + 32 * wc + 16 * (MAP == 3 ? 1 : 0) + (n & 15);
}
template <int MAP> __device__ __forceinline__ void transpose64(const float* W, int K, int N, bf16_t* WT, const float* gk, LAS float* scr, int item, int lane) {
    const int nblk = N / 64, kb = item / nblk, nb = item % nblk, k0 = 64 * kb, n0 = 64 * nb;
    f32x4 v[16];
#pragma unroll
    for (int i = 0; i < 16; ++i) v[i] = *(const GAS f32x4*)(W + (size_t)(k0 + 4 * i + (lane >> 4)) * N + n0 + 4 * (lane & 15));
    if (gk) {
#pragma unroll
        for (int i = 0; i < 16; ++i) v[i] = v[i] * gk[k0 + 4 * i + (lane >> 4)]; }
#pragma unroll
    for (int i = 0; i < 16; ++i) { const int k = 4 * i + (lane >> 4); *(LAS f32x4*)(scr + k * 64 + (((lane & 15) ^ ((k >> 3) & 7)) << 2)) = v[i]; }
    LDS_WAIT(); asm volatile("" ::: "memory");
    const int c = lane & 7, nl = lane >> 3;
#pragma unroll
    for (int r = 0; r < 8; ++r) { const int n = nl + 8 * r; const LAS float* sp = scr + (8 * c) * 64 + ((((n >> 2) ^ c) << 2) | (n & 3));
        u32x4 o; o.x = cvt_pk_bf16(sp[0 * 64], sp[1 * 64]); o.y = cvt_pk_bf16(sp[2 * 64], sp[3 * 64]); o.z = cvt_pk_bf16(sp[4 * 64], sp[5 * 64]); o.w = cvt_pk_bf16(sp[6 * 64], sp[7 * 64]);
        *(GAS u32x4*)(WT + (size_t)dest_row<MAP>(n0 + n) * K + k0 + 8 * c) = o; }
    LDS_WAIT(); asm volatile("" ::: "memory");
}
__device__ __forceinline__ void row_to_bf16(const float* xrow, bf16_t* orow, float* rstd, int lane) {
    const GAS f32x4* xr = (const GAS f32x4*)xrow + lane; f32x4 v[4]; float s = 0.f;
#pragma unroll
    for (int j = 0; j < 4; ++j) { v[j] = xr[64 * j]; s += (v[j].x * v[j].x + v[j].y * v[j].y) + (v[j].z * v[j].z + v[j].w * v[j].w); }
    s = wave_sum(s);
    GAS u32x2* o8 = (GAS u32x2*)orow + lane;
#pragma unroll
    for (int j = 0; j < 4; ++j) o8[64 * j] = pk4(v[j]);
    if (lane == 0) *rstd = rsqrtf(s * (1.f / D) + EPS);
}

__global__ void __launch_bounds__(NWAVES * 64, 2) mk_fwd(Args args) {
    extern __shared__ __attribute__((aligned(16))) unsigned char lds_raw[];
    Frame F; F.lds = (LAS unsigned char*)lds_raw; F.MISC = (volatile LAS unsigned*)(F.lds + MISC_OFF);
    F.tid = threadIdx.x; F.lane = F.tid & 63; F.wave = __builtin_amdgcn_readfirstlane(F.tid >> 6);
    F.G = gridDim.x; { const int bx = blockIdx.x; F.vcu = (F.G % 8 == 0) ? (bx % 8) * (F.G / 8) + bx / 8 : bx; }
    F.ctl = (gu32*)(args.ws + WS_CTL);
#define p_x (args.in[0])
#define p_mem (args.in[1])
#define p_norm_mix_g (args.in[2])
#define p_w_in (args.in[3])
#define p_conv_w (args.in[4])
#define p_conv_b (args.in[5])
#define p_head_norm_g (args.in[6])
#define p_w_out (args.in[7])
#define p_norm_xa_g (args.in[8])
#define p_norm_mem_g (args.in[9])
#define p_w_q (args.in[10])
#define p_w_kv (args.in[11])
#define p_w_o (args.in[12])
#define p_norm_ffn_g (args.in[13])
#define p_w_rg (args.in[14])
#define p_b_rg (args.in[15])
#define p_w_re (args.in[16])
#define p_b_re (args.in[17])
#define p_w_gate (args.in[18])
#define p_w_up (args.in[19])
#define p_w_down (args.in[20])
#define p_final_g (args.in[21])
#define WSP(type, off) ((type*)(args.ws + (off)))
#define Win_t  WSP(bf16_t, WS_WIN)
#define Wout_t WSP(bf16_t, WS_WOUT)
#define Wq_t   WSP(bf16_t, WS_WQ)
#define Wkv_t  WSP(bf16_t, WS_WKV)
#define Wo_t   WSP(bf16_t, WS_WO)
#define KB     WSP(bf16_t, WS_KB)
#define VT     WSP(bf16_t, WS_VT)
#define MB     WSP(bf16_t, WS_MB)
#define LIST   WSP(int, WS_LIST)
#define rstd0  WSP(float, WS_MISC + MS_RSTD0)
#define rstdm  WSP(float, WS_MISC + MS_RSTDM)
#define ssq1   WSP(float, WS_MISC + MS_SSQ1)
#define ssq2   WSP(float, WS_MISC + MS_SSQ2)
#define rstd2  WSP(float, WS_MISC + MS_RSTD2)
#define tokg   WSP(float, WS_MISC + MS_TOKG)
#define WR     WSP(float, WS_MISC + MS_WR)
#define X1     WSP(float, WS_X1)
#define UF     WSP(bf16_t, WS_UF)
#define YF     WSP(float, WS_YF)
#define ACT0   WSP(bf16_t, WS_ACT0)
#define ACT1   WSP(bf16_t, WS_ACT1)
#define WGU    WSP(bf16_t, WS_WGU)
#define WD     WSP(bf16_t, WS_WD)
#define BG     WSP(bf16_t, WS_BG)
#define CV     WSP(bf16_t, WS_CV)
#define Y1     WSP(bf16_t, WS_Y1)
#define CNT    (WSP(int, WS_CTL) + CW_CNT)
    for (int u = F.tid; u < (LDS_BYTES - LDSCTL_OFF) / 4; u += NWAVES * 64) ((LAS unsigned*)(F.lds + LDSCTL_OFF))[u] = 0u;
    __syncthreads();
    XcdBarrier bar = xcd_barrier_post((unsigned*)(F.ctl + CW_BAR), F.MISC + 8);
    const int lo = args.ph_lo, hi = args.ph_hi;
#ifndef MK_MASK
#define MK_MASK 0xffffffffu
#endif
#define IN(k) (((MK_MASK >> (k)) & 1u) && lo <= (k) && (k) < hi)
#define SEAM(k) do { if (IN(k) && IN((k) + 1)) xcd_barrier(bar); } while (0)
#ifndef MK_REP_PHASE
#define MK_REP_PHASE -1
#define MK_REP_N 0
#endif
#define REPS(k) ((k) == MK_REP_PHASE ? 1 + MK_REP_N : 1)
#define PH(k) if (IN(k)) for (int rep_ = 0; rep_ < REPS(k); ++rep_)
#define REPBAR() do { if (rep_) xcd_barrier(bar); } while (0)
    const int gw = F.vcu * NWAVES + F.wave, NGW = F.G * NWAVES;
    constexpr bool SLOW = (MK_SLOW != 0);

    PH(0) { REPBAR();
        LAS float* scr = (LAS float*)(F.lds + F.wave * 16384);
        constexpr int I_IN = 16 * 32, I_SQ = 16 * 16, I_KV = 16 * 32, I_SMALL = I_IN + 3 * I_SQ + I_KV;
        for (int it = gw; it < I_SMALL; it += NGW) { int r = it;
            if (r < I_IN) { transpose64<1>(p_w_in, D, INCOLS, Win_t, p_norm_mix_g, scr, r, F.lane); continue; } r -= I_IN;
            if (r < I_SQ) { transpose64<0>(p_w_out, D, D, Wout_t, nullptr, scr, r, F.lane); continue; } r -= I_SQ;
            if (r < I_SQ) { transpose64<0>(p_w_q, D, D, Wq_t, p_norm_xa_g, scr, r, F.lane); continue; } r -= I_SQ;
            if (r < I_SQ) { transpose64<0>(p_w_o, D, D, Wo_t, nullptr, scr, r, F.lane); continue; } r -= I_SQ;
            transpose64<0>(p_w_kv, D, 2 * D, Wkv_t, p_norm_mem_g, scr, r, F.lane); }
        constexpr int I_G = 16 * 8, I_D = 8 * 16;
        for (int it = gw; it < NEXP * (2 * I_G + I_D); it += NGW) { const int e = it / (2 * I_G + I_D); int r = it % (2 * I_G + I_D);
            if (r < I_G) { transpose64<2>(p_w_gate + (size_t)e * D * DEXP, D, DEXP, WGU + (size_t)e * 1024 * D, p_norm_ffn_g, scr, r, F.lane); continue; } r -= I_G;
            if (r < I_G) { transpose64<3>(p_w_up + (size_t)e * D * DEXP, D, DEXP, WGU + (size_t)e * 1024 * D, p_norm_ffn_g, scr, r, F.lane); continue; } r -= I_G;
            transpose64<0>(p_w_down + (size_t)e * DEXP * D, DEXP, D, WD + (size_t)e * D * DEXP, nullptr, scr, r, F.lane); }
        for (int m = gw; m < T; m += NGW) row_to_bf16(p_x + (size_t)m * D, ACT0 + (size_t)m * D, rstd0 + m, F.lane);
        for (int m = gw; m < NB * MEML; m += NGW) row_to_bf16(p_mem + (size_t)m * D, MB + (size_t)m * D, rstdm + m, F.lane);
        for (int i = blockIdx.x * (NWAVES * 64) + F.tid; i < D * 48; i += F.G * NWAVES * 64) { const int k = i / 48, j = i % 48; WR[i] = j < 4 ? p_norm_ffn_g[k] * p_w_rg[k * 4 + j] : (j < 36 ? p_norm_ffn_g[k] * p_w_re[k * 32 + j - 4] : 0.f); }
        LDS_WAIT(); __syncthreads();
    }
    SEAM(0);
    PH(1) { REPBAR();
        { DenseSched S; S.init(ACT0, Win_t, D, D, T, INCOLS, F.G, (int)blockIdx.x); EpiMix E{rstd0, BG, CV, UF};
          pg8::gemm_phase<EpiMix, DenseSched, true, false, SLOW>(F.lds, D, D, D, S, E); }
        { DenseSched S; S.init(MB, Wkv_t, D, D, NB * MEML, 2 * D, F.G, (int)blockIdx.x); EpiKV E{rstdm, KB, VT};
          pg8::gemm_phase<EpiKV, DenseSched, true, false, SLOW>(F.lds, D, D, D, S, E); }
    }
    SEAM(1);
    PH(2) { REPBAR();
        const int unit = F.vcu;
        if (unit < 256) {
            const int b = unit >> 6, g = (unit >> 3) & 7, cblk = unit & 7;
            LAS unsigned char* zl = F.lds;
#define ZOFF(row, kb) ((row) * 256 + (((((kb) >> 4) ^ ((row) & 15)) << 4) | ((kb) & 15)))
#define SINR(m, n) __builtin_amdgcn_sinf((float)(m) * (1.f / (float)(n)))
#define COSR(m, n) __builtin_amdgcn_cosf((float)(m) * (1.f / (float)(n)))
            const int l = F.lane, lr = l & 15, lq = l >> 4, w = F.wave;
            { bf16x8 f0[2];
#pragma unroll
              for (int kk = 0; kk < 2; ++kk) { unsigned wv[4];
#pragma unroll
                  for (int j2 = 0; j2 < 4; ++j2) { float v[2];
#pragma unroll
                      for (int q = 0; q < 2; ++q) { const int c = kk * 32 + lq * 8 + j2 * 2 + q, cp = cblk * 8 + (lr & 7), m = (c * cp) & 63;
                          v[q] = ((lr >> 3) == 0 ? COSR(m, 64) : -SINR(m, 64)) * (1.f / 512.f); }
                      wv[j2] = cvt_pk_bf16(v[0], v[1]); }
                  f0[kk] = __builtin_bit_cast(bf16x8, (u32x4){wv[0], wv[1], wv[2], wv[3]}); }
              const bf16_t* ub = UF + (size_t)(b * SEQ) * 512 + g * 64;
              for (int mtile = w; mtile < 256; mtile += NWAVES) { const int s2 = mtile >> 2, mt4 = mtile & 3, s1 = 16 * mt4 + lr;
                  const bf16x8 a0 = *(const bf16x8*)(ub + (size_t)(s1 * 64 + s2) * 512 + lq * 8), a1 = *(const bf16x8*)(ub + (size_t)(s1 * 64 + s2) * 512 + 32 + lq * 8);
                  f32x4 d = {0.f, 0.f, 0.f, 0.f};
                  d = __builtin_amdgcn_mfma_f32_16x16x32_bf16(a0, f0[0], d, 0, 0, 0); d = __builtin_amdgcn_mfma_f32_16x16x32_bf16(a1, f0[1], d, 0, 0, 0);
                  const int row = s2 * 8 + (lr & 7), kb = ((lr >> 3) * 64 + 16 * mt4 + 4 * lq) * 2;
                  *(LAS u32x2*)(zl + ZOFF(row, kb)) = pk4(d); } }
            LDS_WAIT(); __syncthreads();
            const int k1t = w & 3, nh = w >> 2;
            u32x2 res[16][2];
            { bf16x8 g1[2][4];
#pragma unroll
              for (int po = 0; po < 2; ++po)
#pragma unroll
                  for (int ks = 0; ks < 4; ++ks) { unsigned wv[4];
#pragma unroll
                      for (int j2 = 0; j2 < 4; ++j2) { float v[2];
#pragma unroll
                          for (int q = 0; q < 2; ++q) { const int K1 = ks * 32 + lq * 8 + j2 * 2 + q, part = K1 >> 6, s1 = K1 & 63, k1 = 16 * k1t + lr, m = (k1 * s1) & 63;
                              v[q] = po == 0 ? (part == 0 ? COSR(m, 64) : SINR(m, 64)) : (part == 0 ? -SINR(m, 64) : COSR(m, 64)); }
                          wv[j2] = cvt_pk_bf16(v[0], v[1]); }
                      g1[po][ks] = __builtin_bit_cast(bf16x8, (u32x4){wv[0], wv[1], wv[2], wv[3]}); }
#pragma unroll
              for (int nti = 0; nti < 16; ++nti) { const int n1 = (nh * 16 + nti) * 16 + lr, s2 = n1 >> 3;
                  f32x4 ar = {0.f, 0.f, 0.f, 0.f}, ai = {0.f, 0.f, 0.f, 0.f};
#pragma unroll
                  for (int ks = 0; ks < 4; ++ks) { const bf16x8 bf = *(const LAS bf16x8*)(zl + ZOFF(n1, (ks * 32 + lq * 8) * 2));
                      ar = __builtin_amdgcn_mfma_f32_16x16x32_bf16(g1[0][ks], bf, ar, 0, 0, 0); ai = __builtin_amdgcn_mfma_f32_16x16x32_bf16(g1[1][ks], bf, ai, 0, 0, 0); }
                  f32x4 tr, ti;
#pragma unroll
                  for (int r = 0; r < 4; ++r) { const int k1 = 16 * k1t + 4 * lq + r, m = (k1 * s2) & 4095; const float cs = COSR(m, 4096), sn = SINR(m, 4096);
                      tr[r] = ar[r] * cs + ai[r] * sn; ti[r] = ai[r] * cs - ar[r] * sn; }
                  res[nti][0] = pk4(tr); res[nti][1] = pk4(ti); } }
            __syncthreads();
#pragma unroll
            for (int nti = 0; nti < 16; ++nti) { const int n1 = (nh * 16 + nti) * 16 + lr, s2 = n1 >> 3, cl = n1 & 7;
#pragma unroll
                for (int part = 0; part < 2; ++part) { const u32x2 v = res[nti][part];
#pragma unroll
                    for (int r = 0; r < 4; ++r) { const int k1 = 16 * k1t + 4 * lq + r; const unsigned h = (r & 2) ? v.y : v.x;
                        *(LAS bf16_t*)(zl + ZOFF(k1 * 8 + cl, (part * 64 + s2) * 2)) = (bf16_t)((r & 1) ? (h >> 16) : (h & 0xffffu)); } } }
            LDS_WAIT(); __syncthreads();
            { bf16x8 h3[4];
#pragma unroll
              for (int ks = 0; ks < 4; ++ks) { unsigned wv[4];
#pragma unroll
                  for (int j2 = 0; j2 < 4; ++j2) { float v[2];
#pragma unroll
                      for (int q = 0; q < 2; ++q) { const int K2 = ks * 32 + lq * 8 + j2 * 2 + q, part = K2 >> 6, s2 = K2 & 63, k2 = 16 * k1t + lr, m = (k2 * s2) & 63;
                          v[q] = part == 0 ? COSR(m, 64) : SINR(m, 64); }
                      wv[j2] = cvt_pk_bf16(v[0], v[1]); }
                  h3[ks] = __builtin_bit_cast(bf16x8, (u32x4){wv[0], wv[1], wv[2], wv[3]}); }
              float* yb = YF + (size_t)(b * SEQ) * 512 + g * 64 + cblk * 8;
#pragma unroll 4
              for (int nti = 0; nti < 16; ++nti) { const int n2 = (nh * 16 + nti) * 16 + lr, k1 = n2 >> 3, cl = n2 & 7;
                  f32x4 acc = {0.f, 0.f, 0.f, 0.f};
#pragma unroll
                  for (int ks = 0; ks < 4; ++ks) { const bf16x8 bf = *(const LAS bf16x8*)(zl + ZOFF(n2, (ks * 32 + lq * 8) * 2)); acc = __builtin_amdgcn_mfma_f32_16x16x32_bf16(h3[ks], bf, acc, 0, 0, 0); }
#pragma unroll
                  for (int r = 0; r < 4; ++r) { const int k2 = 16 * k1t + 4 * lq + r; yb[(size_t)(k1 + 64 * k2) * 512 + cl] = acc[r]; } } }
            LDS_WAIT(); __syncthreads();
#undef ZOFF
#undef SINR
#undef COSR
        }
    }
    SEAM(2);
    PH(3) { REPBAR();
        for (int t = gw; t < T; t += NGW) { const int s = t % SEQ, l = F.lane, c0 = 8 * l;
            const bf16x8 bgv = *(const bf16x8*)(BG + (size_t)t * 512 + c0), cv0 = *(const bf16x8*)(CV + (size_t)t * 512 + c0);
            bf16x8 cvm = {0, 0, 0, 0, 0, 0, 0, 0}, cvp = {0, 0, 0, 0, 0, 0, 0, 0};
            if (s > 0) cvm = *(const bf16x8*)(CV + (size_t)(t - 1) * 512 + c0);
            if (s < SEQ - 1) cvp = *(const bf16x8*)(CV + (size_t)(t + 1) * 512 + c0);
            float y[8], f[8]; float sy = 0.f, sf = 0.f;
#pragma unroll
            for (int j = 0; j < 8; ++j) { const int c = c0 + j;
                const float z = p_conv_b[c] + bf2f((unsigned short)cvm[j]) * p_conv_w[c] + bf2f((unsigned short)cv0[j]) * p_conv_w[512 + c] + bf2f((unsigned short)cvp[j]) * p_conv_w[1024 + c];
                y[j] = bf2f((unsigned short)bgv[j]) * z; sy += y[j] * y[j];
                f[j] = YF[(size_t)t * 512 + c]; sf += f[j] * f[j]; }
            sy += __shfl_xor(sy, 1); sy += __shfl_xor(sy, 2); sy += __shfl_xor(sy, 4); sf += __shfl_xor(sf, 1); sf += __shfl_xor(sf, 2); sf += __shfl_xor(sf, 4);
            const float ry = rsqrtf(sy * (1.f / 64.f) + EPS), rf = rsqrtf(sf * (1.f / 64.f) + EPS);
            u32x4 oy, of;
            oy.x = cvt_pk_bf16(y[0] * ry * p_head_norm_g[c0 + 0], y[1] * ry * p_head_norm_g[c0 + 1]); oy.y = cvt_pk_bf16(y[2] * ry * p_head_norm_g[c0 + 2], y[3] * ry * p_head_norm_g[c0 + 3]);
            oy.z = cvt_pk_bf16(y[4] * ry * p_head_norm_g[c0 + 4], y[5] * ry * p_head_norm_g[c0 + 5]); oy.w = cvt_pk_bf16(y[6] * ry * p_head_norm_g[c0 + 6], y[7] * ry * p_head_norm_g[c0 + 7]);
            of.x = cvt_pk_bf16(f[0] * rf * p_head_norm_g[512 + c0 + 0], f[1] * rf * p_head_norm_g[512 + c0 + 1]); of.y = cvt_pk_bf16(f[2] * rf * p_head_norm_g[512 + c0 + 2], f[3] * rf * p_head_norm_g[512 + c0 + 3]);
            of.z = cvt_pk_bf16(f[4] * rf * p_head_norm_g[512 + c0 + 4], f[5] * rf * p_head_norm_g[512 + c0 + 5]); of.w = cvt_pk_bf16(f[6] * rf * p_head_norm_g[512 + c0 + 6], f[7] * rf * p_head_norm_g[512 + c0 + 7]);
            *(u32x4*)(ACT1 + (size_t)t * D + c0) = oy; *(u32x4*)(ACT1 + (size_t)t * D + 512 + c0) = of; }
    }
    SEAM(3);
    PH(4) { REPBAR(); DenseSched S; S.init(ACT1, Wout_t, D, D, T, D, F.G, (int)blockIdx.x); EpiRes E{p_x, X1, ACT0, ssq1};
        pg8::gemm_phase<EpiRes, DenseSched, false, false, SLOW>(F.lds, D, D, D, S, E); }
    SEAM(4);
    PH(5) { REPBAR(); DenseSched S; S.init(ACT0, Wq_t, D, D, T, D, F.G, (int)blockIdx.x); EpiBf16 E{ACT1, D, ssq1, QSCALE};
        pg8::gemm_phase<EpiBf16, DenseSched, false, false, SLOW>(F.lds, D, D, D, S, E); }
    SEAM(5);
    PH(6) { REPBAR(); AttnSched<0> S{(const char*)ACT1, (const char*)KB, (int)blockIdx.x}; EpiSoftmax E{ACT0};
        pg8::gemm_phase<EpiSoftmax, AttnSched<0>, false, false, SLOW>(F.lds, D, D, 256, S, E); }
    SEAM(6);
    PH(7) { REPBAR(); AttnSched<1> S{(const char*)ACT0, (const char*)VT, (int)blockIdx.x}; EpiBf16 E{ACT1, D, nullptr, 1.f};
        pg8::gemm_phase<EpiBf16, AttnSched<1>, false, false, SLOW>(F.lds, D, MEML, 256, S, E); }
    SEAM(7);
    PH(8) { REPBAR(); DenseSched S; S.init(ACT1, Wo_t, D, D, T, D, F.G, (int)blockIdx.x); EpiRes E{X1, X1, ACT0, ssq2};
        pg8::gemm_phase<EpiRes, DenseSched, false, false, SLOW>(F.lds, D, D, D, S, E); }
    SEAM(8);
    PH(9) { REPBAR();
        LAS float* sl = (LAS float*)(F.lds + F.wave * 4096);
        for (int it = gw; it < T / 16; it += NGW) { const int t0 = it * 16, row = F.lane & 15, q = F.lane >> 4;
            f32x4 acc0 = {0.f, 0.f, 0.f, 0.f}, acc1 = acc0, acc2 = acc0;
            const float* xr = X1 + (size_t)(t0 + row) * D + 4 * q;
            for (int j = 0; j < 64; ++j) { const f32x4 a = *(const f32x4*)(xr + 16 * j);
#pragma unroll
                for (int i = 0; i < 4; ++i) { const float* wp = WR + (size_t)(16 * j + 4 * q + i) * 48 + row;
                    acc0 = __builtin_amdgcn_mfma_f32_16x16x4f32(a[i], wp[0], acc0, 0, 0, 0); acc1 = __builtin_amdgcn_mfma_f32_16x16x4f32(a[i], wp[16], acc1, 0, 0, 0); acc2 = __builtin_amdgcn_mfma_f32_16x16x4f32(a[i], wp[32], acc2, 0, 0, 0); } }
#pragma unroll
            for (int r = 0; r < 4; ++r) { sl[(4 * q + r) * 52 + row] = acc0[r]; sl[(4 * q + r) * 52 + 16 + row] = acc1[r]; sl[(4 * q + r) * 52 + 32 + row] = acc2[r]; }
            LDS_WAIT(); __builtin_amdgcn_wave_barrier();
            if (F.lane < 16) { const int t = t0 + F.lane; LAS float* L = sl + F.lane * 52;
                const float rs = rsqrtf(((ssq2[t] + ssq2[T + t]) + (ssq2[2 * T + t] + ssq2[3 * T + t])) * (1.f / D) + EPS);
                float gm = -1e30f; int gi = 0;
                for (int j = 0; j < 4; ++j) { const float v = L[j] * rs + p_b_rg[j]; if (v > gm) { gm = v; gi = j; } }
                float gs = 0.f; for (int j = 0; j < 4; ++j) gs += __expf(L[j] * rs + p_b_rg[j] - gm);
                const float gwt = 1.f / gs;
                float em = -1e30f;
                for (int j = 0; j < 8; ++j) { const float v = L[4 + gi * 8 + j] * rs + p_b_re[gi * 8 + j]; L[40 + j] = v; em = fmaxf(em, v); }
                float es = 0.f; for (int j = 0; j < 8; ++j) { const float p = __expf(L[40 + j] - em); L[40 + j] = p; es += p; }
                int i0 = 0; float p0 = L[40];
                for (int j = 1; j < 8; ++j) { const float p = L[40 + j]; if (p > p0) { p0 = p; i0 = j; } }
                int i1 = -1; float p1 = -1.f;
                for (int j = 0; j < 8; ++j) { const float p = L[40 + j]; if (j != i0 && p > p1) { p1 = p; i1 = j; } }
                p0 /= es; p1 /= es; const float ssum = p0 + p1; const int e0 = gi * 8 + i0, e1 = gi * 8 + i1;
                rstd2[t] = rs; tokg[t * 2] = gwt * p0 / ssum; tokg[t * 2 + 1] = gwt * p1 / ssum;
                const int q0 = atomicAdd(&CNT[e0], 1); LIST[e0 * T + q0] = t * 2;
                const int q1 = atomicAdd(&CNT[e1], 1); LIST[e1 * T + q1] = t * 2 + 1; }
            LDS_WAIT(); __builtin_amdgcn_wave_barrier(); }
    }
    SEAM(9);
    LAS int* tp = (LAS int*)(F.lds + MOE_TP_OFF); LAS int* lcnt = tp + 40; LAS int* lbase = tp + 80;
    if (IN(10) || IN(11)) {
        if (F.tid == 0) { int a = 0, bsum = 0; for (int e = 0; e < NEXP; ++e) { const int c = __hip_atomic_load((const int*)&CNT[e], RLX_AGENT); tp[e] = a; lcnt[e] = c; lbase[e] = bsum; a += (c + 255) >> 8; bsum += c; } tp[NEXP] = a; lbase[NEXP] = bsum; }
        LDS_WAIT(); __syncthreads();
    }
    PH(10) { REPBAR(); MoeSched<0> S{(const char*)ACT0, (const char*)WGU, LIST, tp, lcnt, lbase, F.G, (int)blockIdx.x}; EpiGU E{LIST, lcnt, rstd2, ACT1};
        pg8::gemm_phase<EpiGU, MoeSched<0>, true, true, SLOW>(F.lds, D, D, D, S, E); }
    SEAM(10);
    PH(11) { REPBAR(); MoeSched<1> S{(const char*)ACT1, (const char*)WD, LIST, tp, lcnt, lbase, F.G, (int)blockIdx.x}; EpiDown E{LIST, lcnt, tokg, ACT0, Y1};
        pg8::gemm_phase<EpiDown, MoeSched<1>, true, false, SLOW>(F.lds, DEXP, DEXP, DEXP, S, E); }
    SEAM(11);
    PH(12) { REPBAR();
        for (int t = gw; t < T; t += NGW) { f32x4 v[4]; float s = 0.f;
#pragma unroll
            for (int j = 0; j < 4; ++j) { const size_t o = (size_t)t * D + 4 * F.lane + 256 * j; v[j] = *(const f32x4*)(X1 + o);
                const u32x2 a = *(const u32x2*)(ACT0 + o), b = *(const u32x2*)(Y1 + o);
                v[j][0] += __uint_as_float(a.x << 16) + __uint_as_float(b.x << 16); v[j][1] += __uint_as_float(a.x & 0xffff0000u) + __uint_as_float(b.x & 0xffff0000u);
                v[j][2] += __uint_as_float(a.y << 16) + __uint_as_float(b.y << 16); v[j][3] += __uint_as_float(a.y & 0xffff0000u) + __uint_as_float(b.y & 0xffff0000u);
                s += (v[j][0] * v[j][0] + v[j][1] * v[j][1]) + (v[j][2] * v[j][2] + v[j][3] * v[j][3]); }
            const float r = rsqrtf(wave_sum(s) * (1.f / D) + EPS);
#pragma unroll
            for (int j = 0; j < 4; ++j) { const int c = 4 * F.lane + 256 * j; const f32x4 g = *(const f32x4*)(p_final_g + c); *(f32x4*)(args.out + (size_t)t * D + c) = v[j] * r * g; } }
    }
#undef IN
#undef SEAM
}

constexpr int NPHASE = 13;
extern "C" void kernel_launch(void* const* d_in, const int* in_sizes, int n_in, void* d_out, int out_size, void* d_ws, size_t ws_size, hipStream_t stream) {
    static int grid = 0;
    if (grid == 0) {
        if (n_in != 22 || out_size != T * D || ws_size < WS_END) { fprintf(stderr, "kernel_launch: unexpected problem (n_in %d out %d ws %zu)\n", n_in, out_size, ws_size); grid = -1; return; }
        int dev = 0, cus = 0, per_cu = 0;
        if (hipGetDevice(&dev) != hipSuccess || hipDeviceGetAttribute(&cus, hipDeviceAttributeMultiprocessorCount, dev) != hipSuccess) { grid = -1; return; }
        if (hipFuncSetAttribute((const void*)mk_fwd, hipFuncAttributeMaxDynamicSharedMemorySize, LDS_BYTES) != hipSuccess) { fprintf(stderr, "kernel_launch: hipFuncSetAttribute failed\n"); grid = -1; return; }
        if (hipOccupancyMaxActiveBlocksPerMultiprocessor(&per_cu, (const void*)mk_fwd, NWAVES * 64, LDS_BYTES) != hipSuccess || per_cu < 1) { fprintf(stderr, "kernel_launch: occupancy query says %d\n", per_cu); per_cu = 1; }
        (void)hipGetLastError();
        grid = cus;
        if (grid != 256) fprintf(stderr, "kernel_launch: %d CUs (built for 256)\n", grid);
    }
    if (grid < 0) return;
    (void)hipMemsetAsync((char*)d_ws + WS_CTL, 0, CTL_ZERO_BYTES, stream);
    Args a{};
    for (int i = 0; i < 22; ++i) a.in[i] = (const float*)d_in[i];
    a.out = (float*)d_out; a.ws = (unsigned char*)d_ws; a.ph_lo = 0; a.ph_hi = NPHASE;
    hipLaunchKernelGGL(mk_fwd, dim3(grid), dim3(NWAVES * 64), LDS_BYTES, stream, a);
}
```

```cpp
#include <hip/hip_runtime.h>
#include <cstdint>
#include <cstdio>

#ifndef MK_FENCE_ALL
#define MK_FENCE_ALL 0
#endif
#ifndef MK_PROBE_PHASE
#define MK_PROBE_PHASE -1
#endif
#ifndef MK_SLOW
#define MK_SLOW 0
#endif

#define LAS __attribute__((address_space(3)))
#define GAS __attribute__((address_space(1)))
typedef unsigned short bf16_t;
typedef short bf16x8 __attribute__((ext_vector_type(8)));
typedef float f32x4 __attribute__((ext_vector_type(4)));
typedef float f32x2 __attribute__((ext_vector_type(2)));
typedef unsigned u32x4 __attribute__((ext_vector_type(4)));
typedef unsigned u32x2 __attribute__((ext_vector_type(2)));
typedef GAS unsigned gu32;

constexpr int T = 16384, D = 1024, SEQ = 4096, NB = 4, MEML = 256, NEXP = 32, DEXP = 512, INCOLS = 2048;
constexpr float EPS = 1e-6f;
constexpr float QSCALE = 0.0625f * 1.4426950408889634f;
constexpr int NWAVES = 8;

constexpr size_t MiB = 1u << 20;
constexpr size_t WS_CTL = 0, CTL_ZERO_BYTES = 1 * MiB;
constexpr size_t WS_WIN = 1 * MiB, WS_WOUT = 5 * MiB, WS_WQ = 7 * MiB, WS_WKV = 9 * MiB, WS_WO = 13 * MiB;
constexpr size_t WS_KB = 15 * MiB, WS_VT = 17 * MiB, WS_MB = 19 * MiB, WS_LIST = 21 * MiB, WS_MISC = 23 * MiB;
constexpr size_t MS_RSTD0 = 0, MS_RSTDM = 64 * 1024, MS_SSQ1 = 128 * 1024, MS_SSQ2 = 384 * 1024, MS_RSTD2 = 640 * 1024, MS_TOKG = 704 * 1024, MS_WR = 832 * 1024;
constexpr size_t WS_X1 = 24 * MiB;
constexpr size_t WS_UF = 24 * MiB, WS_YF = 40 * MiB;
constexpr size_t WS_ACT0 = 88 * MiB, WS_ACT1 = 120 * MiB;
constexpr size_t WS_WGU = 152 * MiB, WS_WD = 216 * MiB;
constexpr size_t WS_BG = 248 * MiB, WS_CV = 264 * MiB, WS_Y1 = 248 * MiB, WS_END = 280 * MiB;
constexpr int CW_BAR = 4096, CW_CNT = 16384;

constexpr int RING_BYTES = 131072, LDSCTL_OFF = RING_BYTES, MISC_OFF = LDSCTL_OFF + 320, LDS_BYTES = 147456;
constexpr int MOE_TP_OFF = LDSCTL_OFF + 1024;

#define RLX_AGENT __ATOMIC_RELAXED, __HIP_MEMORY_SCOPE_AGENT
#define LDS_WAIT() asm volatile("s_waitcnt lgkmcnt(0)" ::: "memory")
#define VM_WAIT() asm volatile("s_waitcnt vmcnt(0)" ::: "memory")
typedef __bf16 bf16x2_t __attribute__((ext_vector_type(2)));
__device__ __forceinline__ unsigned cvt_pk_bf16(float lo, float hi) { const f32x2 v = {lo, hi}; const bf16x2_t b = __builtin_convertvector(v, bf16x2_t); return __builtin_bit_cast(unsigned, b); }
__device__ __forceinline__ u32x2 pk4(f32x4 v) { u32x2 w; w.x = cvt_pk_bf16(v[0], v[1]); w.y = cvt_pk_bf16(v[2], v[3]); return w; }
__device__ __forceinline__ float bf2f(unsigned short h) { return __uint_as_float((unsigned)h << 16); }
__device__ __forceinline__ float wave_sum(float v) {
#pragma unroll
    for (int o = 1; o < 64; o <<= 1) v += __shfl_xor(v, o);
    return v;
}

#define XB_TMO      128
#define XB_XCNT(j)  (256  + 64 * (j))
#define XB_XSUB(j)  (1280 + 64 * (j))
#define XB_XGEN(j)  (2304 + 64 * (j))
#define XB_TOP      3328
#define XB_TOPGEN   3392
#define XCD_BAR_WORDS 3456
#define XB_SPIN_CAP (1u << 18)
__device__ __forceinline__ unsigned xb_ld(unsigned* p)              { return __hip_atomic_load(p, __ATOMIC_RELAXED, __HIP_MEMORY_SCOPE_AGENT); }
__device__ __forceinline__ unsigned xb_add(unsigned* p, unsigned v) { return __hip_atomic_fetch_add(p, v, __ATOMIC_RELAXED, __HIP_MEMORY_SCOPE_AGENT); }
__device__ __forceinline__ unsigned xb_xcc_id() { return (unsigned)__builtin_amdgcn_s_getreg((3 << 11) | 20) & 0xFu; }
#define XB_SPIN(cond, bar) do { unsigned _sp = 0; while (cond) { __builtin_amdgcn_s_sleep(1); \
    if ((++_sp & 255u) == 0u) { if (xb_ld(&(bar)[XB_TMO])) break; if (_sp > XB_SPIN_CAP) { atomicAdd(&(bar)[XB_TMO], 1u); break; } } } } while (0)
struct XcdBarrier { unsigned* bar; unsigned x; volatile LAS unsigned* st; };
__device__ __forceinline__ XcdBarrier xcd_barrier_post(unsigned* bar, volatile LAS unsigned* st) {
    XcdBarrier b; b.bar = bar; b.x = xb_xcc_id(); b.st = st;
    if (threadIdx.x == 0) (void)xb_add(&bar[XB_XCNT(b.x)], 1u);
    return b;
}
__device__ __forceinline__ void xcd_barrier_complete(unsigned* bar, unsigned x, unsigned& nloc, unsigned& nx) {
    const unsigned G = gridDim.x * gridDim.y * gridDim.z;
    unsigned sum, cnt, mine, sp = 0u;
    for (;;) {
        sum = 0u; cnt = 0u; mine = 0u;
#pragma unroll
        for (unsigned j = 0; j < 16; ++j) { const unsigned c = xb_ld(&bar[XB_XCNT(j)]); sum += c; cnt += (c > 0u) ? 1u : 0u; mine = (j == x) ? c : mine; }
        if (sum == G) break;
        __builtin_amdgcn_s_sleep(1);
        if ((++sp & 255u) == 0u) { if (xb_ld(&bar[XB_TMO])) break; if (sp > XB_SPIN_CAP) { atomicAdd(&bar[XB_TMO], 1u); break; } }
    }
    nloc = mine > 0u ? mine : 1u; nx = cnt > 0u ? cnt : 1u;
}
__device__ __forceinline__ void xcd_barrier(const XcdBarrier& b) {
    asm volatile("s_waitcnt vmcnt(0)" ::: "memory");
#if MK_FENCE_ALL
    __threadfence(); asm volatile("s_waitcnt vmcnt(0)" ::: "memory");
#endif
    __syncthreads();
    if (threadIdx.x == 0) {
        unsigned* bar = b.bar;
        __builtin_amdgcn_s_waitcnt(0);
        unsigned nloc = b.st[0], nx = b.st[1];
        if (nloc == 0u) { xcd_barrier_complete(bar, b.x, nloc, nx); b.st[0] = nloc; b.st[1] = nx; }
        const unsigned old = xb_add(&bar[XB_XSUB(b.x)], 1u);
        const unsigned gen = old / nloc;
        if (old + 1u == (gen + 1u) * nloc) {
            __builtin_amdgcn_fence(__ATOMIC_RELEASE, "agent");
            asm volatile("s_waitcnt vmcnt(0)" ::: "memory");
            const unsigned og = xb_add(&bar[XB_TOP], 1u);
            const unsigned tg = og / nx;
            if (og + 1u == (tg + 1u) * nx) xb_add(&bar[XB_TOPGEN], 1u);
            else XB_SPIN(xb_ld(&bar[XB_TOPGEN]) == tg, bar);
            __builtin_amdgcn_fence(__ATOMIC_ACQUIRE, "agent");
            xb_add(&bar[XB_XGEN(b.x)], 1u);
            asm volatile("s_waitcnt vmcnt(0)" ::: "memory");
        } else {
            XB_SPIN(xb_ld(&bar[XB_XGEN(b.x)]) == gen, bar);
            __builtin_amdgcn_fence(__ATOMIC_ACQUIRE, "agent");
            asm volatile("s_waitcnt vmcnt(0)" ::: "memory");
        }
    }
    __syncthreads();
#if MK_FENCE_ALL
    __threadfence(); asm volatile("s_waitcnt vmcnt(0)" ::: "memory"); __syncthreads();
#endif
}

namespace pg8 {
constexpr int BM = 256, BK = 64, HALF = 128, HTB = HALF * BK * 2, STAGE_BYTES = 8 * HTB;
__host__ __device__ __forceinline__ int lds_byte(int r, int c) { const int st = (r >> 4) * 2 + (c >> 5), rr = r & 15, cc = c & 31, ob = rr * 64 + cc * 2; return st * 1024 + (ob ^ (((ob >> 9) & 1) << 5)); }
__host__ __device__ __forceinline__ void stage_rc(int b, int& R, int& C) { const int st = b / 1024, sb = b % 1024, swz = sb ^ (((sb >> 9) & 1) << 5); R = (st >> 1) * 16 + swz / 64; C = (st & 1) * 32 + (swz % 64) / 2; }

struct Unit { const char* a; const char* b; int crow, ccol, z, e; };

typedef f32x4 Acc[2][2][4][2];

template <class Epi, class Sched, bool ALIGN_EPI, bool GATHER, bool SLOW>
__device__ __forceinline__ void gemm_phase(LAS unsigned char* lds, const int lda, const int ldb, const int K, const Sched& S, const Epi& E) {
    const int tid = threadIdx.x, wid = __builtin_amdgcn_readfirstlane(tid >> 6), lane = tid & 63, wr = wid >> 2, wc = wid & 3, fr = lane & 15, fq = lane >> 4;
    Unit cur, nxt; int ui = 0;
    if (!S.next(0, cur)) return;
    Acc acc;
#define PG8_ZERO() do { _Pragma("unroll") for (int a_ = 0; a_ < 2; ++a_) _Pragma("unroll") for (int b_ = 0; b_ < 2; ++b_) _Pragma("unroll") for (int m_ = 0; m_ < 4; ++m_) _Pragma("unroll") for (int n_ = 0; n_ < 2; ++n_) acc[a_][b_][m_][n_] = (f32x4){0.f, 0.f, 0.f, 0.f}; } while (0)
    if constexpr (SLOW) {
        for (;;) {
            PG8_ZERO();
            unsigned ao[2][4], bo[2][2];
#pragma unroll
            for (int ai = 0; ai < 2; ++ai)
#pragma unroll
                for (int m = 0; m < 4; ++m) { const int row = ai * 128 + wr * 64 + m * 16 + fr; ao[ai][m] = (unsigned)(GATHER ? S.gather_row(cur, row) : row) * (unsigned)lda * 2u + (unsigned)fq * 16u; }
#pragma unroll
            for (int bj = 0; bj < 2; ++bj)
#pragma unroll
                for (int n = 0; n < 2; ++n) bo[bj][n] = (unsigned)(bj * 128 + wc * 32 + n * 16 + fr) * (unsigned)ldb * 2u + (unsigned)fq * 16u;
#pragma unroll 1
            for (int k0 = 0; k0 < K; k0 += 32) {
                bf16x8 af[2][4], bfr[2][2];
#pragma unroll
                for (int ai = 0; ai < 2; ++ai)
#pragma unroll
                    for (int m = 0; m < 4; ++m) af[ai][m] = *(const bf16x8*)(cur.a + ao[ai][m] + (size_t)k0 * 2);
#pragma unroll
                for (int bj = 0; bj < 2; ++bj)
#pragma unroll
                    for (int n = 0; n < 2; ++n) bfr[bj][n] = *(const bf16x8*)(cur.b + bo[bj][n] + (size_t)k0 * 2);
#pragma unroll
                for (int ai = 0; ai < 2; ++ai)
#pragma unroll
                    for (int bj = 0; bj < 2; ++bj)
#pragma unroll
                        for (int m = 0; m < 4; ++m)
#pragma unroll
                            for (int n = 0; n < 2; ++n) acc[ai][bj][m][n] = __builtin_amdgcn_mfma_f32_16x16x32_bf16(bfr[bj][n], af[ai][m], acc[ai][bj][m][n], 0, 0, 0);
            }
            if constexpr (!Epi::AFTER_DRAIN) { E(acc, cur, wr, wc, fr, fq); }
            else { __syncthreads(); E.fused(acc, cur, wr, wc, fr, fq, lds, wid, lane); __syncthreads(); }
            ++ui; if (!S.next(ui, cur)) break;
        }
        return;
    } else {
    const int nt = K / BK;
    unsigned voffA[2], voffB[2], voffC[2];
#pragma unroll
    for (int i = 0; i < 2; ++i) { int R, C; stage_rc(tid * 16 + i * 8192, R, C); voffA[i] = (unsigned)(R * lda + C) * 2u; voffB[i] = (unsigned)(R * ldb + C) * 2u; voffC[i] = (unsigned)C * 2u; }
    const unsigned hstepA = (unsigned)HALF * (unsigned)lda * 2u, hstepB = (unsigned)HALF * (unsigned)ldb * 2u;
    const size_t kstep = (size_t)(BK * 2);
    const unsigned ldsw = (unsigned)wid * 1024u;
    const int aoff = lds_byte(wr * 64 + fr, fq * 8), boff = lds_byte(wc * 32 + fr, fq * 8);
    unsigned vg[2][2];
#define PG8_GROWS(vg, u) do { _Pragma("unroll") for (int h_ = 0; h_ < 2; ++h_) _Pragma("unroll") for (int i_ = 0; i_ < 2; ++i_) { int R_, C_; stage_rc(tid * 16 + i_ * 8192, R_, C_); \
        vg[h_][i_] = (unsigned)S.gather_row(u, h_ * HALF + R_) * (unsigned)lda * 2u + voffC[i_]; } } while (0)
#define PG8_SA(b, h) (((b) * 2 + (h)) * HTB)
#define PG8_SB(b, h) ((4 + (b) * 2 + (h)) * HTB)
#define PG8_GLDS(src, dstoff) __builtin_amdgcn_global_load_lds((const unsigned*)(src), (LAS unsigned*)(lds + (dstoff)), 16, 0, 0)
#define PG8_STAGE_B(bufoff, gbase) do { _Pragma("unroll") for (int _i = 0; _i < 2; ++_i) PG8_GLDS((const char*)(gbase) + voffB[_i], (bufoff) + ldsw + _i * 8192); } while (0)
#define PG8_STAGE_A(bufoff, kptr, h, nx) do { _Pragma("unroll") for (int _i = 0; _i < 2; ++_i) { \
        const unsigned vo_ = GATHER ? vg[h][_i] : (voffA[_i] + (unsigned)(h) * hstepA); PG8_GLDS((const char*)(kptr) + vo_, (bufoff) + ldsw + _i * 8192); } } while (0)
#define PG8_LDA(dst, b, h) do { _Pragma("unroll") for (int m = 0; m < 4; ++m) _Pragma("unroll") for (int k = 0; k < 2; ++k) dst[m][k] = *(const LAS bf16x8*)(lds + PG8_SA(b, h) + aoff + m * 2048 + k * 1024); } while (0)
#define PG8_LDB(dst, b, h) do { _Pragma("unroll") for (int n = 0; n < 2; ++n) _Pragma("unroll") for (int k = 0; k < 2; ++k) dst[n][k] = *(const LAS bf16x8*)(lds + PG8_SB(b, h) + boff + n * 2048 + k * 1024); } while (0)
#define PG8_MMA(ai, bj, At, Bt) do { __builtin_amdgcn_s_setprio(1); _Pragma("unroll") for (int m = 0; m < 4; ++m) _Pragma("unroll") for (int n = 0; n < 2; ++n) _Pragma("unroll") for (int k = 0; k < 2; ++k) \
        acc[ai][bj][m][n] = __builtin_amdgcn_mfma_f32_16x16x32_bf16(Bt[n][k], At[m][k], acc[ai][bj][m][n], 0, 0, 0); __builtin_amdgcn_s_setprio(0); } while (0)
#define PG8_WAIT_V(n) asm volatile("s_waitcnt vmcnt(" #n ")" ::: "memory")
#define PG8_WAIT_L(n) asm volatile("s_waitcnt lgkmcnt(" #n ")" ::: "memory")
#define PG8_BAR __builtin_amdgcn_s_barrier()
#define PG8_SCHED __builtin_amdgcn_sched_barrier(0)
    PG8_ZERO();
    bf16x8 At[4][2], B0[2][2], B1[2][2];
    const char* cA = cur.a; const char* cB = cur.b;
    if constexpr (GATHER) { PG8_GROWS(vg, cur); }
    PG8_STAGE_B(PG8_SB(0, 0), cB); PG8_STAGE_B(PG8_SB(0, 1), cB + hstepB); PG8_STAGE_A(PG8_SA(0, 0), cA, 0, false); PG8_STAGE_A(PG8_SA(0, 1), cA, 1, false);
    if (wr == 1) PG8_BAR;
    PG8_WAIT_V(2); PG8_BAR;
    PG8_STAGE_B(PG8_SB(1, 0), cB + kstep); PG8_STAGE_A(PG8_SA(1, 0), cA + kstep, 0, false); PG8_STAGE_B(PG8_SB(1, 1), cB + hstepB + kstep);
    PG8_WAIT_V(6); PG8_BAR;
    for (;;) {
        const bool has_next = S.next(ui + 1, nxt);
        const char* nA = has_next ? nxt.a : cA; const char* nB = has_next ? nxt.b : cB;
        for (int t = 0; t < nt; t += 2) {
            const bool last = (t == nt - 2);
            const char* a1 = cA + (size_t)(t + 1) * kstep;
            const char* a2 = last ? nA : cA + (size_t)(t + 2) * kstep; const char* b2 = last ? nB : cB + (size_t)(t + 2) * kstep;
            const char* a3 = a2 + kstep; const char* b3 = b2 + kstep;
            PG8_LDB(B0, 0, 0); PG8_LDB(B1, 0, 1); PG8_SCHED; PG8_LDA(At, 0, 0); PG8_STAGE_A(PG8_SA(1, 1), a1, 1, false);
            if constexpr (GATHER) { if (last && has_next) { PG8_GROWS(vg, nxt); } }
            PG8_WAIT_V(8); PG8_WAIT_L(0); PG8_BAR; PG8_MMA(0, 0, At, B0); PG8_MMA(0, 1, At, B1); PG8_BAR; PG8_SCHED;
            PG8_LDA(At, 0, 1); PG8_STAGE_B(PG8_SB(0, 0), b2); PG8_STAGE_B(PG8_SB(0, 1), b2 + hstepB); PG8_STAGE_A(PG8_SA(0, 0), a2, 0, last);
            PG8_WAIT_V(8); PG8_WAIT_L(0); PG8_BAR; PG8_MMA(1, 0, At, B0); PG8_MMA(1, 1, At, B1); PG8_BAR; PG8_SCHED;
            PG8_LDB(B0, 1, 0); PG8_LDB(B1, 1, 1); PG8_SCHED; PG8_LDA(At, 1, 0); PG8_STAGE_A(PG8_SA(0, 1), a2, 1, last);
            PG8_WAIT_V(8); PG8_WAIT_L(0); PG8_BAR; PG8_MMA(0, 0, At, B0); PG8_MMA(0, 1, At, B1); PG8_BAR; PG8_SCHED;
            PG8_LDA(At, 1, 1); PG8_STAGE_B(PG8_SB(1, 0), b3); PG8_STAGE_B(PG8_SB(1, 1), b3 + hstepB); PG8_STAGE_A(PG8_SA(1, 0), a3, 0, last);
            PG8_WAIT_V(8); PG8_WAIT_L(0); PG8_BAR; PG8_MMA(1, 0, At, B0); PG8_MMA(1, 1, At, B1); PG8_BAR; PG8_SCHED;
        }
        if constexpr (ALIGN_EPI) { if (wr == 0) PG8_BAR; }
        if constexpr (!Epi::AFTER_DRAIN) { E(acc, cur, wr, wc, fr, fq); }
        if (!has_next) break;
        PG8_WAIT_V(0);
        PG8_ZERO();
        cur = nxt; cA = nA; cB = nB; ++ui;
        if constexpr (ALIGN_EPI) { if (wr == 1) PG8_BAR; }
    }
    PG8_WAIT_V(0);
    if constexpr (!ALIGN_EPI) { if (wr == 0) PG8_BAR; }
    PG8_BAR;
    if constexpr (Epi::AFTER_DRAIN) { E.fused(acc, cur, wr, wc, fr, fq, lds, wid, lane); }
#undef PG8_SA
#undef PG8_SB
#undef PG8_GLDS
#undef PG8_STAGE_A
#undef PG8_STAGE_B
#undef PG8_LDA
#undef PG8_LDB
#undef PG8_MMA
#undef PG8_WAIT_V
#undef PG8_WAIT_L
#undef PG8_BAR
#undef PG8_SCHED
#undef PG8_GROWS
    }
#undef PG8_ZERO
}
}
using pg8::Unit; using pg8::Acc;

struct DenseSched {
    const char* A; const char* Bt; int lda, ldb, nM, nN, nwg, G, c;
    __device__ __forceinline__ void init(const void* A_, const void* Bt_, int lda_, int ldb_, int M, int N, int G_, int c_) { A = (const char*)A_; Bt = (const char*)Bt_; lda = lda_; ldb = ldb_; nM = M / 256; nN = N / 256; nwg = nM * nN; G = G_; c = c_; }
    __device__ __forceinline__ bool next(int i, Unit& u) const {
        const long L = (long)i * G + c; if (L >= nwg) return false;
        int wgid = (int)L; { const int q = nwg / 8, r = nwg % 8, xcd = wgid % 8, off = wgid / 8; wgid = (xcd < r ? xcd * (q + 1) : r * (q + 1) + (xcd - r) * q) + off; }
        const int nig = 8 * nN, gid = wgid / nig, fm = gid * 8, gsz = (nM - fm) < 8 ? (nM - fm) : 8;
        const int pm = fm + ((wgid % nig) % gsz), pn = (wgid % nig) / gsz;
        u.a = A + (size_t)pm * 256 * lda * 2; u.b = Bt + (size_t)pn * 256 * ldb * 2; u.crow = pm * 256; u.ccol = pn * 256; u.z = pn; u.e = 0; return true;
    }
    __device__ __forceinline__ int gather_row(const Unit&, int r) const { return r; }
};
template <int MODE> struct AttnSched {
    const char* A; const char* B; int c;
    __device__ __forceinline__ bool next(int i, Unit& u) const {
        if (i > 0 || c >= 256) return false;
        const int vc = (c & 7) * 32 + (c >> 3);
        const int bh = vc >> 4, pm = vc & 15, b = bh >> 2, h = bh & 3;
        u.a = A + ((size_t)(b * SEQ + pm * 256) * D + h * 256) * 2;
        u.b = MODE == 0 ? B + ((size_t)(b * MEML) * D + h * 256) * 2 : B + ((size_t)(b * D + h * 256) * MEML) * 2;
        u.crow = b * SEQ + pm * 256; u.ccol = h * 256; u.z = bh; u.e = 0; return true;
    }
    __device__ __forceinline__ int gather_row(const Unit&, int r) const { return r; }
};
template <int MODE  > struct MoeSched {
    const char* A; const char* Bw; const int* list; const LAS int* tp; const LAS int* cnt; const LAS int* base; int G, c;
    __device__ __forceinline__ bool next(int i, Unit& u) const {
        const int L = i * G + c; const int tile = L >> 2, pn = L & 3;
        if (tile >= tp[NEXP]) return false;
        int e = 0;
        for (int j = 1; j < NEXP; ++j) e += (tp[j] <= tile) ? 1 : 0;
        const int mt = tile - tp[e];
        u.e = e; u.z = mt; u.crow = base[e] + mt * 256; u.ccol = pn * 256;
        if (MODE == 0) { u.a = A; u.b = Bw + ((size_t)e * 1024 + pn * 256) * D * 2; }
        else { u.a = A + (size_t)(base[e] + mt * 256) * DEXP * 2; u.b = Bw + ((size_t)e * D + pn * 256) * DEXP * 2; }
        return true;
    }
    __device__ __forceinline__ int gather_row(const Unit& u, int r) const {
        const int p = u.z * 256 + r; return p < cnt[u.e] ? (list[u.e * T + p] >> 1) : 0;
    }
};

#define EPI_ROW(ai, m) ((ai) * 128 + wr * 64 + (m) * 16 + fr)
#define EPI_COL(bj, n) ((bj) * 128 + wc * 32 + (n) * 16 + 4 * fq)
struct EpiMix {
    static constexpr bool AFTER_DRAIN = false;
    const float* rstd0; bf16_t* bg; bf16_t* cv; bf16_t* uf;
    __device__ __forceinline__ void operator()(const Acc& acc, const Unit& u, int wr, int wc, int fr, int fq) const {
        const int ch = u.z * 64 + wc * 16 + 4 * fq;
#pragma unroll
        for (int ai = 0; ai < 2; ++ai)
#pragma unroll
            for (int m = 0; m < 4; ++m) { const int row = u.crow + EPI_ROW(ai, m); const float r = rstd0[row];
                const f32x4 b = acc[ai][0][m][0] * r, c = acc[ai][0][m][1] * r, v = acc[ai][1][m][0] * r, f = acc[ai][1][m][1] * r;
                const size_t o = (size_t)row * 512 + ch;
                *(u32x2*)(bg + o) = pk4(b); *(u32x2*)(cv + o) = pk4(c * v); *(u32x2*)(uf + o) = pk4(f); }
    }
};
struct EpiKV {
    static constexpr bool AFTER_DRAIN = false;
    const float* rstdm; bf16_t* kb; bf16_t* vt;
    __device__ __forceinline__ void operator()(const Acc& acc, const Unit& u, int wr, int wc, int fr, int fq) const {
#pragma unroll
        for (int ai = 0; ai < 2; ++ai)
#pragma unroll
            for (int m = 0; m < 4; ++m) { const int row = u.crow + EPI_ROW(ai, m); const float r = rstdm[row];
#pragma unroll
                for (int bj = 0; bj < 2; ++bj)
#pragma unroll
                    for (int n = 0; n < 2; ++n) { const int col = u.ccol + EPI_COL(bj, n); const f32x4 v = acc[ai][bj][m][n] * r;
                        if (col < D) *(u32x2*)(kb + (size_t)row * D + col) = pk4(v);
                        else { const int b = row >> 8, key = row & 255; const u32x2 w = pk4(v); bf16_t* p = vt + ((size_t)b * D + (col - D)) * MEML + key;
                            p[0] = (bf16_t)(w.x & 0xffffu); p[MEML] = (bf16_t)(w.x >> 16); p[2 * MEML] = (bf16_t)(w.y & 0xffffu); p[3 * MEML] = (bf16_t)(w.y >> 16); } } }
    }
};
struct EpiF32 {
    static constexpr bool AFTER_DRAIN = false;
    float* C; int ldc;
    __device__ __forceinline__ void operator()(const Acc& acc, const Unit& u, int wr, int wc, int fr, int fq) const {
#pragma unroll
        for (int ai = 0; ai < 2; ++ai)
#pragma unroll
            for (int m = 0; m < 4; ++m) { float* rowp = C + (size_t)(u.crow + EPI_ROW(ai, m)) * ldc + u.ccol;
#pragma unroll
                for (int bj = 0; bj < 2; ++bj)
#pragma unroll
                    for (int n = 0; n < 2; ++n) *(f32x4*)(rowp + EPI_COL(bj, n)) = acc[ai][bj][m][n]; }
    }
};
struct EpiBf16 {
    static constexpr bool AFTER_DRAIN = false;
    bf16_t* O; int ldc; const float* ssq; float cs;
    __device__ __forceinline__ void operator()(const Acc& acc, const Unit& u, int wr, int wc, int fr, int fq) const {
#pragma unroll
        for (int ai = 0; ai < 2; ++ai)
#pragma unroll
            for (int m = 0; m < 4; ++m) { const int row = u.crow + EPI_ROW(ai, m); float r = cs;
                if (ssq) r *= rsqrtf(((ssq[row] + ssq[T + row]) + (ssq[2 * T + row] + ssq[3 * T + row])) * (1.f / D) + EPS);
                bf16_t* rowp = O + (size_t)row * ldc + u.ccol;
#pragma unroll
                for (int bj = 0; bj < 2; ++bj)
#pragma unroll
                    for (int n = 0; n < 2; ++n) *(u32x2*)(rowp + EPI_COL(bj, n)) = pk4(acc[ai][bj][m][n] * r); }
    }
};
struct EpiRes {
    static constexpr bool AFTER_DRAIN = true;
    const float* xin; float* xo; bf16_t* xb; float* ssq;
    __device__ __forceinline__ void fused(Acc& acc, const Unit& u, int wr, int wc, int fr, int fq, LAS unsigned char* lds, int wid, int lane) const {
        LAS float* P = (LAS float*)lds;
#pragma unroll
        for (int ai = 0; ai < 2; ++ai)
#pragma unroll
            for (int m = 0; m < 4; ++m) { const int rl = EPI_ROW(ai, m); const size_t ro = (size_t)(u.crow + rl) * D + u.ccol; float s = 0.f;
#pragma unroll
                for (int bj = 0; bj < 2; ++bj)
#pragma unroll
                    for (int n = 0; n < 2; ++n) { const size_t o = ro + EPI_COL(bj, n); const f32x4 v = *(const f32x4*)(xin + o) + acc[ai][bj][m][n];
                        *(f32x4*)(xo + o) = v; *(u32x2*)(xb + o) = pk4(v); s += (v[0] * v[0] + v[1] * v[1]) + (v[2] * v[2] + v[3] * v[3]); }
                s += __shfl_xor(s, 16); s += __shfl_xor(s, 32);
                if (fq == 0) P[rl * 4 + wc] = s; }
        LDS_WAIT(); __syncthreads();
        const int tid = wid * 64 + lane;
        if (tid < 256) ssq[(size_t)u.z * T + u.crow + tid] = (P[tid * 4 + 0] + P[tid * 4 + 1]) + (P[tid * 4 + 2] + P[tid * 4 + 3]);
        LDS_WAIT(); __syncthreads();
    }
};
struct EpiSoftmax {
    static constexpr bool AFTER_DRAIN = true;
    bf16_t* Pm;
    __device__ __forceinline__ void fused(Acc& acc, const Unit& u, int wr, int wc, int fr, int fq, LAS unsigned char* lds, int wid, int lane) const {
        LAS float* PM = (LAS float*)lds; LAS float* PS = (LAS float*)(lds + 4096);
#pragma unroll
        for (int ai = 0; ai < 2; ++ai)
#pragma unroll
            for (int m = 0; m < 4; ++m) { float mx = -1e30f;
#pragma unroll
                for (int bj = 0; bj < 2; ++bj)
#pragma unroll
                    for (int n = 0; n < 2; ++n) { const f32x4 v = acc[ai][bj][m][n]; mx = fmaxf(mx, fmaxf(fmaxf(v[0], v[1]), fmaxf(v[2], v[3]))); }
                mx = fmaxf(mx, __shfl_xor(mx, 16)); mx = fmaxf(mx, __shfl_xor(mx, 32));
                if (fq == 0) PM[EPI_ROW(ai, m) * 4 + wc] = mx; }
        LDS_WAIT(); __syncthreads();
#pragma unroll
        for (int ai = 0; ai < 2; ++ai)
#pragma unroll
            for (int m = 0; m < 4; ++m) { const int rl = EPI_ROW(ai, m); const float mx = fmaxf(fmaxf(PM[rl * 4], PM[rl * 4 + 1]), fmaxf(PM[rl * 4 + 2], PM[rl * 4 + 3])); float s = 0.f;
#pragma unroll
                for (int bj = 0; bj < 2; ++bj)
#pragma unroll
                    for (int n = 0; n < 2; ++n) { f32x4 v = acc[ai][bj][m][n];
#pragma unroll
                        for (int i = 0; i < 4; ++i) { v[i] = __builtin_amdgcn_exp2f(v[i] - mx); s += v[i]; }
                        acc[ai][bj][m][n] = v; }
                s += __shfl_xor(s, 16); s += __shfl_xor(s, 32);
                if (fq == 0) PS[rl * 4 + wc] = s; }
        LDS_WAIT(); __syncthreads();
#pragma unroll
        for (int ai = 0; ai < 2; ++ai)
#pragma unroll
            for (int m = 0; m < 4; ++m) { const int rl = EPI_ROW(ai, m); const float inv = 1.f / ((PS[rl * 4] + PS[rl * 4 + 1]) + (PS[rl * 4 + 2] + PS[rl * 4 + 3]));
                bf16_t* rowp = Pm + (size_t)(u.crow + rl) * D + u.ccol;
#pragma unroll
                for (int bj = 0; bj < 2; ++bj)
#pragma unroll
                    for (int n = 0; n < 2; ++n) *(u32x2*)(rowp + EPI_COL(bj, n)) = pk4(acc[ai][bj][m][n] * inv); }
        LDS_WAIT(); __syncthreads();
    }
};
struct EpiGU {
    static constexpr bool AFTER_DRAIN = false;
    const int* list; const LAS int* cnt; const float* rstd2; bf16_t* hmid;
    __device__ __forceinline__ void operator()(const Acc& acc, const Unit& u, int wr, int wc, int fr, int fq) const {
        const int pn = u.ccol >> 8;
#pragma unroll
        for (int ai = 0; ai < 2; ++ai)
#pragma unroll
            for (int m = 0; m < 4; ++m) { const int rl = EPI_ROW(ai, m), p = u.z * 256 + rl;
                if (p < cnt[u.e]) { const int tok = list[u.e * T + p] >> 1; const float r = rstd2[tok];
#pragma unroll
                    for (int bj = 0; bj < 2; ++bj) { const f32x4 a = acc[ai][bj][m][0] * r, b = acc[ai][bj][m][1] * r; f32x4 h;
#pragma unroll
                        for (int i = 0; i < 4; ++i) h[i] = a[i] / (1.f + __expf(-a[i])) * b[i];
                        *(u32x2*)(hmid + (size_t)(u.crow + rl) * DEXP + pn * 128 + bj * 64 + wc * 16 + 4 * fq) = pk4(h); } } }
    }
};
struct EpiDown {
    static constexpr bool AFTER_DRAIN = false;
    const int* list; const LAS int* cnt; const float* tokg; bf16_t* y0; bf16_t* y1;
    __device__ __forceinline__ void operator()(const Acc& acc, const Unit& u, int wr, int wc, int fr, int fq) const {
#pragma unroll
        for (int ai = 0; ai < 2; ++ai)
#pragma unroll
            for (int m = 0; m < 4; ++m) { const int rl = EPI_ROW(ai, m), p = u.z * 256 + rl;
                if (p < cnt[u.e]) { const int ent = list[u.e * T + p]; const float g = tokg[ent]; bf16_t* rowp = ((ent & 1) ? y1 : y0) + (size_t)(ent >> 1) * D + u.ccol;
#pragma unroll
                    for (int bj = 0; bj < 2; ++bj)
#pragma unroll
                        for (int n = 0; n < 2; ++n) *(u32x2*)(rowp + EPI_COL(bj, n)) = pk4(acc[ai][bj][m][n] * g); } }
    }
};

struct Args { const float* in[22]; float* out; unsigned char* ws; int ph_lo, ph_hi; };
struct Frame { LAS unsigned char* lds; volatile LAS unsigned* MISC; gu32* ctl; int tid, lane, wave, vcu, G; };

template <int MAP> __device__ __forceinline__ int dest_row(int n) {
    if (MAP == 0) return n;
    if (MAP == 1) { const int sec = n < 1536 ? n / 512 : 3, within = n < 1536 ? n % 512 : n - 1536, pn = within >> 6, ch = within & 63;
        return pn * 256 + 128 * (sec >> 1) + 32 * (ch >> 4) + 16 * (sec & 1) + (ch & 15); }
    const int pn = n >> 7, bj = (n >> 6) & 1, wc = (n >> 4) & 3; return pn * 256 + 128 * bj + 32 * wc + 16 * (MAP == 3 ? 1 : 0) + (n & 15);
}
template <int MAP> __device__ __forceinline__ void transpose64(const float* W, int K, int N, bf16_t* WT, const float* gk, LAS float* scr, int item, int lane) {
    const int nblk = N / 64, kb = item / nblk, nb = item % nblk, k0 = 64 * kb, n0 = 64 * nb;
    f32x4 v[16];
#pragma unroll
    for (int i = 0; i < 16; ++i) v[i] = *(const GAS f32x4*)(W + (size_t)(k0 + 4 * i + (lane >> 4)) * N + n0 + 4 * (lane & 15));
    if (gk) {
#pragma unroll
        for (int i = 0; i < 16; ++i) v[i] = v[i] * gk[k0 + 4 * i + (lane >> 4)]; }
#pragma unroll
    for (int i = 0; i < 16; ++i) { const int k = 4 * i + (lane >> 4); *(LAS f32x4*)(scr + k * 64 + (((lane & 15) ^ ((k >> 3) & 7)) << 2)) = v[i]; }
    LDS_WAIT(); asm volatile("" ::: "memory");
    const int c = lane & 7, nl = lane >> 3;
#pragma unroll
    for (int r = 0; r < 8; ++r) { const int n = nl + 8 * r; const LAS float* sp = scr + (8 * c) * 64 + ((((n >> 2) ^ c) << 2) | (n & 3));
        u32x4 o; o.x = cvt_pk_bf16(sp[0 * 64], sp[1 * 64]); o.y = cvt_pk_bf16(sp[2 * 64], sp[3 * 64]); o.z = cvt_pk_bf16(sp[4 * 64], sp[5 * 64]); o.w = cvt_pk_bf16(sp[6 * 64], sp[7 * 64]);
        *(GAS u32x4*)(WT + (size_t)dest_row<MAP>(n0 + n) * K + k0 + 8 * c) = o; }
    LDS_WAIT(); asm volatile("" ::: "memory");
}
__device__ __forceinline__ void row_to_bf16(const float* xrow, bf16_t* orow, float* rstd, int lane) {
    const GAS f32x4* xr = (const GAS f32x4*)xrow + lane; f32x4 v[4]; float s = 0.f;
#pragma unroll
    for (int j = 0; j < 4; ++j) { v[j] = xr[64 * j]; s += (v[j].x * v[j].x + v[j].y * v[j].y) + (v[j].z * v[j].z + v[j].w * v[j].w); }
    s = wave_sum(s);
    GAS u32x2* o8 = (GAS u32x2*)orow + lane;
#pragma unroll
    for (int j = 0; j < 4; ++j) o8[64 * j] = pk4(v[j]);
    if (lane == 0) *rstd = rsqrtf(s * (1.f / D) + EPS);
}

__global__ void __launch_bounds__(NWAVES * 64, 2) mk_fwd(Args args) {
    extern __shared__ __attribute__((aligned(16))) unsigned char lds_raw[];
    Frame F; F.lds = (LAS unsigned char*)lds_raw; F.MISC = (volatile LAS unsigned*)(F.lds + MISC_OFF);
    F.tid = threadIdx.x; F.lane = F.tid & 63; F.wave = __builtin_amdgcn_readfirstlane(F.tid >> 6);
    F.G = gridDim.x; { const int bx = blockIdx.x; F.vcu = (F.G % 8 == 0) ? (bx % 8) * (F.G / 8) + bx / 8 : bx; }
    F.ctl = (gu32*)(args.ws + WS_CTL);
#define p_x (args.in[0])
#define p_mem (args.in[1])
#define p_norm_mix_g (args.in[2])
#define p_w_in (args.in[3])
#define p_conv_w (args.in[4])
#define p_conv_b (args.in[5])
#define p_head_norm_g (args.in[6])
#define p_w_out (args.in[7])
#define p_norm_xa_g (args.in[8])
#define p_norm_mem_g (args.in[9])
#define p_w_q (args.in[10])
#define p_w_kv (args.in[11])
#define p_w_o (args.in[12])
#define p_norm_ffn_g (args.in[13])
#define p_w_rg (args.in[14])
#define p_b_rg (args.in[15])
#define p_w_re (args.in[16])
#define p_b_re (args.in[17])
#define p_w_gate (args.in[18])
#define p_w_up (args.in[19])
#define p_w_down (args.in[20])
#define p_final_g (args.in[21])
#define WSP(type, off) ((type*)(args.ws + (off)))
#define Win_t  WSP(bf16_t, WS_WIN)
#define Wout_t WSP(bf16_t, WS_WOUT)
#define Wq_t   WSP(bf16_t, WS_WQ)
#define Wkv_t  WSP(bf16_t, WS_WKV)
#define Wo_t   WSP(bf16_t, WS_WO)
#define KB     WSP(bf16_t, WS_KB)
#define VT     WSP(bf16_t, WS_VT)
#define MB     WSP(bf16_t, WS_MB)
#define LIST   WSP(int, WS_LIST)
#define rstd0  WSP(float, WS_MISC + MS_RSTD0)
#define rstdm  WSP(float, WS_MISC + MS_RSTDM)
#define ssq1   WSP(float, WS_MISC + MS_SSQ1)
#define ssq2   WSP(float, WS_MISC + MS_SSQ2)
#define rstd2  WSP(float, WS_MISC + MS_RSTD2)
#define tokg   WSP(float, WS_MISC + MS_TOKG)
#define WR     WSP(float, WS_MISC + MS_WR)
#define X1     WSP(float, WS_X1)
#define UF     WSP(bf16_t, WS_UF)
#define YF     WSP(float, WS_YF)
#define ACT0   WSP(bf16_t, WS_ACT0)
#define ACT1   WSP(bf16_t, WS_ACT1)
#define WGU    WSP(bf16_t, WS_WGU)
#define WD     WSP(bf16_t, WS_WD)
#define BG     WSP(bf16_t, WS_BG)
#define CV     WSP(bf16_t, WS_CV)
#define Y1     WSP(bf16_t, WS_Y1)
#define CNT    (WSP(int, WS_CTL) + CW_CNT)
    for (int u = F.tid; u < (LDS_BYTES - LDSCTL_OFF) / 4; u += NWAVES * 64) ((LAS unsigned*)(F.lds + LDSCTL_OFF))[u] = 0u;
    __syncthreads();
    XcdBarrier bar = xcd_barrier_post((unsigned*)(F.ctl + CW_BAR), F.MISC + 8);
    const int lo = args.ph_lo, hi = args.ph_hi;
#ifndef MK_MASK
#define MK_MASK 0xffffffffu
#endif
#define IN(k) (((MK_MASK >> (k)) & 1u) && lo <= (k) && (k) < hi)
#define SEAM(k) do { if (IN(k) && IN((k) + 1)) xcd_barrier(bar); } while (0)
#ifndef MK_REP_PHASE
#define MK_REP_PHASE -1
#define MK_REP_N 0
#endif
#define REPS(k) ((k) == MK_REP_PHASE ? 1 + MK_REP_N : 1)
#define PH(k) if (IN(k)) for (int rep_ = 0; rep_ < REPS(k); ++rep_)
#define REPBAR() do { if (rep_) xcd_barrier(bar); } while (0)
    const int gw = F.vcu * NWAVES + F.wave, NGW = F.G * NWAVES;
    constexpr bool SLOW = (MK_SLOW != 0);

    PH(0) { REPBAR();
        LAS float* scr = (LAS float*)(F.lds + F.wave * 16384);
        constexpr int I_IN = 16 * 32, I_SQ = 16 * 16, I_KV = 16 * 32, I_SMALL = I_IN + 3 * I_SQ + I_KV;
        for (int it = gw; it < I_SMALL; it += NGW) { int r = it;
            if (r < I_IN) { transpose64<1>(p_w_in, D, INCOLS, Win_t, p_norm_mix_g, scr, r, F.lane); continue; } r -= I_IN;
            if (r < I_SQ) { transpose64<0>(p_w_out, D, D, Wout_t, nullptr, scr, r, F.lane); continue; } r -= I_SQ;
            if (r < I_SQ) { transpose64<0>(p_w_q, D, D, Wq_t, p_norm_xa_g, scr, r, F.lane); continue; } r -= I_SQ;
            if (r < I_SQ) { transpose64<0>(p_w_o, D, D, Wo_t, nullptr, scr, r, F.lane); continue; } r -= I_SQ;
            transpose64<0>(p_w_kv, D, 2 * D, Wkv_t, p_norm_mem_g, scr, r, F.lane); }
        constexpr int I_G = 16 * 8, I_D = 8 * 16;
        for (int it = gw; it < NEXP * (2 * I_G + I_D); it += NGW) { const int e = it / (2 * I_G + I_D); int r = it % (2 * I_G + I_D);
            if (r < I_G) { transpose64<2>(p_w_gate + (size_t)e * D * DEXP, D, DEXP, WGU + (size_t)e * 1024 * D, p_norm_ffn_g, scr, r, F.lane); continue; } r -= I_G;
            if (r < I_G) { transpose64<3>(p_w_up + (size_t)e * D * DEXP, D, DEXP, WGU + (size_t)e * 1024 * D, p_norm_ffn_g, scr, r, F.lane); continue; } r -= I_G;
            transpose64<0>(p_w_down + (size_t)e * DEXP * D, DEXP, D, WD + (size_t)e * D * DEXP, nullptr, scr, r, F.lane); }
        for (int m = gw; m < T; m += NGW) row_to_bf16(p_x + (size_t)m * D, ACT0 + (size_t)m * D, rstd0 + m, F.lane);
        for (int m = gw; m < NB * MEML; m += NGW) row_to_bf16(p_mem + (size_t)m * D, MB + (size_t)m * D, rstdm + m, F.lane);
        for (int i = blockIdx.x * (NWAVES * 64) + F.tid; i < D * 48; i += F.G * NWAVES * 64) { const int k = i / 48, j = i % 48; WR[i] = j < 4 ? p_norm_ffn_g[k] * p_w_rg[k * 4 + j] : (j < 36 ? p_norm_ffn_g[k] * p_w_re[k * 32 + j - 4] : 0.f); }
        LDS_WAIT(); __syncthreads();
    }
    SEAM(0);
    PH(1) { REPBAR();
        { DenseSched S; S.init(ACT0, Win_t, D, D, T, INCOLS, F.G, (int)blockIdx.x); EpiMix E{rstd0, BG, CV, UF};
          pg8::gemm_phase<EpiMix, DenseSched, true, false, SLOW>(F.lds, D, D, D, S, E); }
        { DenseSched S; S.init(MB, Wkv_t, D, D, NB * MEML, 2 * D, F.G, (int)blockIdx.x); EpiKV E{rstdm, KB, VT};
          pg8::gemm_phase<EpiKV, DenseSched, true, false, SLOW>(F.lds, D, D, D, S, E); }
    }
    SEAM(1);
    PH(2) { REPBAR();
        const int unit = F.vcu;
        if (unit < 256) {
            const int b = unit >> 6, g = (unit >> 3) & 7, cblk = unit & 7;
            LAS unsigned char* zl = F.lds;
#define ZOFF(row, kb) ((row) * 256 + (((((kb) >> 4) ^ ((row) & 15)) << 4) | ((kb) & 15)))
#define SINR(m, n) __builtin_amdgcn_sinf((float)(m) * (1.f / (float)(n)))
#define COSR(m, n) __builtin_amdgcn_cosf((float)(m) * (1.f / (float)(n)))
            const int l = F.lane, lr = l & 15, lq = l >> 4, w = F.wave;
            { bf16x8 f0[2];
#pragma unroll
              for (int kk = 0; kk < 2; ++kk) { unsigned wv[4];
#pragma unroll
                  for (int j2 = 0; j2 < 4; ++j2) { float v[2];
#pragma unroll
                      for (int q = 0; q < 2; ++q) { const int c = kk * 32 + lq * 8 + j2 * 2 + q, cp = cblk * 8 + (lr & 7), m = (c * cp) & 63;
                          v[q] = ((lr >> 3) == 0 ? COSR(m, 64) : -SINR(m, 64)) * (1.f / 512.f); }
                      wv[j2] = cvt_pk_bf16(v[0], v[1]); }
                  f0[kk] = __builtin_bit_cast(bf16x8, (u32x4){wv[0], wv[1], wv[2], wv[3]}); }
              const bf16_t* ub = UF + (size_t)(b * SEQ) * 512 + g * 64;
              for (int mtile = w; mtile < 256; mtile += NWAVES) { const int s2 = mtile >> 2, mt4 = mtile & 3, s1 = 16 * mt4 + lr;
                  const bf16x8 a0 = *(const bf16x8*)(ub + (size_t)(s1 * 64 + s2) * 512 + lq * 8), a1 = *(const bf16x8*)(ub + (size_t)(s1 * 64 + s2) * 512 + 32 + lq * 8);
                  f32x4 d = {0.f, 0.f, 0.f, 0.f};
                  d = __builtin_amdgcn_mfma_f32_16x16x32_bf16(a0, f0[0], d, 0, 0, 0); d = __builtin_amdgcn_mfma_f32_16x16x32_bf16(a1, f0[1], d, 0, 0, 0);
                  const int row = s2 * 8 + (lr & 7), kb = ((lr >> 3) * 64 + 16 * mt4 + 4 * lq) * 2;
                  *(LAS u32x2*)(zl + ZOFF(row, kb)) = pk4(d); } }
            LDS_WAIT(); __syncthreads();
            const int k1t = w & 3, nh = w >> 2;
            u32x2 res[16][2];
            { bf16x8 g1[2][4];
#pragma unroll
              for (int po = 0; po < 2; ++po)
#pragma unroll
                  for (int ks = 0; ks < 4; ++ks) { unsigned wv[4];
#pragma unroll
                      for (int j2 = 0; j2 < 4; ++j2) { float v[2];
#pragma unroll
                          for (int q = 0; q < 2; ++q) { const int K1 = ks * 32 + lq * 8 + j2 * 2 + q, part = K1 >> 6, s1 = K1 & 63, k1 = 16 * k1t + lr, m = (k1 * s1) & 63;
                              v[q] = po == 0 ? (part == 0 ? COSR(m, 64) : SINR(m, 64)) : (part == 0 ? -SINR(m, 64) : COSR(m, 64)); }
                          wv[j2] = cvt_pk_bf16(v[0], v[1]); }
                      g1[po][ks] = __builtin_bit_cast(bf16x8, (u32x4){wv[0], wv[1], wv[2], wv[3]}); }
#pragma unroll
              for (int nti = 0; nti < 16; ++nti) { const int n1 = (nh * 16 + nti) * 16 + lr, s2 = n1 >> 3;
                  f32x4 ar = {0.f, 0.f, 0.f, 0.f}, ai = {0.f, 0.f, 0.f, 0.f};
#pragma unroll
                  for (int ks = 0; ks < 4; ++ks) { const bf16x8 bf = *(const LAS bf16x8*)(zl + ZOFF(n1, (ks * 32 + lq * 8) * 2));
                      ar = __builtin_amdgcn_mfma_f32_16x16x32_bf16(g1[0][ks], bf, ar, 0, 0, 0); ai = __builtin_amdgcn_mfma_f32_16x16x32_bf16(g1[1][ks], bf, ai, 0, 0, 0); }
                  f32x4 tr, ti;
#pragma unroll
                  for (int r = 0; r < 4; ++r) { const int k1 = 16 * k1t + 4 * lq + r, m = (k1 * s2) & 4095; const float cs = COSR(m, 4096), sn = SINR(m, 4096);
                      tr[r] = ar[r] * cs + ai[r] * sn; ti[r] = ai[r] * cs - ar[r] * sn; }
                  res[nti][0] = pk4(tr); res[nti][1] = pk4(ti); } }
            __syncthreads();
#pragma unroll
            for (int nti = 0; nti < 16; ++nti) { const int n1 = (nh * 16 + nti) * 16 + lr, s2 = n1 >> 3, cl = n1 & 7;
#pragma unroll
                for (int part = 0; part < 2; ++part) { const u32x2 v = res[nti][part];
#pragma unroll
                    for (int r = 0; r < 4; ++r) { const int k1 = 16 * k1t + 4 * lq + r; const unsigned h = (r & 2) ? v.y : v.x;
                        *(LAS bf16_t*)(zl + ZOFF(k1 * 8 + cl, (part * 64 + s2) * 2)) = (bf16_t)((r & 1) ? (h >> 16) : (h & 0xffffu)); } } }
            LDS_WAIT(); __syncthreads();
            { bf16x8 h3[4];
#pragma unroll
              for (int ks = 0; ks < 4; ++ks) { unsigned wv[4];
#pragma unroll
                  for (int j2 = 0; j2 < 4; ++j2) { float v[2];
#pragma unroll
                      for (int q = 0; q < 2; ++q) { const int K2 = ks * 32 + lq * 8 + j2 * 2 + q, part = K2 >> 6, s2 = K2 & 63, k2 = 16 * k1t + lr, m = (k2 * s2) & 63;
                          v[q] = part == 0 ? COSR(m, 64) : SINR(m, 64); }
                      wv[j2] = cvt_pk_bf16(v[0], v[1]); }
                  h3[ks] = __builtin_bit_cast(bf16x8, (u32x4){wv[0], wv[1], wv[2], wv[3]}); }
              float* yb = YF + (size_t)(b * SEQ) * 512 + g * 64 + cblk * 8;
#pragma unroll 4
              for (int nti = 0; nti < 16; ++nti) { const int n2 = (nh * 16 + nti) * 16 + lr, k1 = n2 >> 3, cl = n2 & 7;
                  f32x4 acc = {0.f, 0.f, 0.f, 0.f};
#pragma unroll
                  for (int ks = 0; ks < 4; ++ks) { const bf16x8 bf = *(const LAS bf16x8*)(zl + ZOFF(n2, (ks * 32 + lq * 8) * 2)); acc = __builtin_amdgcn_mfma_f32_16x16x32_bf16(h3[ks], bf, acc, 0, 0, 0); }
#pragma unroll
                  for (int r = 0; r < 4; ++r) { const int k2 = 16 * k1t + 4 * lq + r; yb[(size_t)(k1 + 64 * k2) * 512 + cl] = acc[r]; } } }
            LDS_WAIT(); __syncthreads();
#undef ZOFF
#undef SINR
#undef COSR
        }
    }
    SEAM(2);
    PH(3) { REPBAR();
        for (int t = gw; t < T; t += NGW) { const int s = t % SEQ, l = F.lane, c0 = 8 * l;
            const bf16x8 bgv = *(const bf16x8*)(BG + (size_t)t * 512 + c0), cv0 = *(const bf16x8*)(CV + (size_t)t * 512 + c0);
            bf16x8 cvm = {0, 0, 0, 0, 0, 0, 0, 0}, cvp = {0, 0, 0, 0, 0, 0, 0, 0};
            if (s > 0) cvm = *(const bf16x8*)(CV + (size_t)(t - 1) * 512 + c0);
            if (s < SEQ - 1) cvp = *(const bf16x8*)(CV + (size_t)(t + 1) * 512 + c0);
            float y[8], f[8]; float sy = 0.f, sf = 0.f;
#pragma unroll
            for (int j = 0; j < 8; ++j) { const int c = c0 + j;
                const float z = p_conv_b[c] + bf2f((unsigned short)cvm[j]) * p_conv_w[c] + bf2f((unsigned short)cv0[j]) * p_conv_w[512 + c] + bf2f((unsigned short)cvp[j]) * p_conv_w[1024 + c];
                y[j] = bf2f((unsigned short)bgv[j]) * z; sy += y[j] * y[j];
                f[j] = YF[(size_t)t * 512 + c]; sf += f[j] * f[j]; }
            sy += __shfl_xor(sy, 1); sy += __shfl_xor(sy, 2); sy += __shfl_xor(sy, 4); sf += __shfl_xor(sf, 1); sf += __shfl_xor(sf, 2); sf += __shfl_xor(sf, 4);
            const float ry = rsqrtf(sy * (1.f / 64.f) + EPS), rf = rsqrtf(sf * (1.f / 64.f) + EPS);
            u32x4 oy, of;
            oy.x = cvt_pk_bf16(y[0] * ry * p_head_norm_g[c0 + 0], y[1] * ry * p_head_norm_g[c0 + 1]); oy.y = cvt_pk_bf16(y[2] * ry * p_head_norm_g[c0 + 2], y[3] * ry * p_head_norm_g[c0 + 3]);
            oy.z = cvt_pk_bf16(y[4] * ry * p_head_norm_g[c0 + 4], y[5] * ry * p_head_norm_g[c0 + 5]); oy.w = cvt_pk_bf16(y[6] * ry * p_head_norm_g[c0 + 6], y[7] * ry * p_head_norm_g[c0 + 7]);
            of.x = cvt_pk_bf16(f[0] * rf * p_head_norm_g[512 + c0 + 0], f[1] * rf * p_head_norm_g[512 + c0 + 1]); of.y = cvt_pk_bf16(f[2] * rf * p_head_norm_g[512 + c0 + 2], f[3] * rf * p_head_norm_g[512 + c0 + 3]);
            of.z = cvt_pk_bf16(f[4] * rf * p_head_norm_g[512 + c0 + 4], f[5] * rf * p_head_norm_g[512 + c0 + 5]); of.w = cvt_pk_bf16(f[6] * rf * p_head_norm_g[512 + c0 + 6], f[7] * rf * p_head_norm_g[512 + c0 + 7]);
            *(u32x4*)(ACT1 + (size_t)t * D + c0) = oy; *(u32x4*)(ACT1 + (size_t)t * D + 512 + c0) = of; }
    }
    SEAM(3);
    PH(4) { REPBAR(); DenseSched S; S.init(ACT1, Wout_t, D, D, T, D, F.G, (int)blockIdx.x); EpiRes E{p_x, X1, ACT0, ssq1};
        pg8::gemm_phase<EpiRes, DenseSched, false, false, SLOW>(F.lds, D, D, D, S, E); }
    SEAM(4);
    PH(5) { REPBAR(); DenseSched S; S.init(ACT0, Wq_t, D, D, T, D, F.G, (int)blockIdx.x); EpiBf16 E{ACT1, D, ssq1, QSCALE};
        pg8::gemm_phase<EpiBf16, DenseSched, false, false, SLOW>(F.lds, D, D, D, S, E); }
    SEAM(5);
    PH(6) { REPBAR(); AttnSched<0> S{(const char*)ACT1, (const char*)KB, (int)blockIdx.x}; EpiSoftmax E{ACT0};
        pg8::gemm_phase<EpiSoftmax, AttnSched<0>, false, false, SLOW>(F.lds, D, D, 256, S, E); }
    SEAM(6);
    PH(7) { REPBAR(); AttnSched<1> S{(const char*)ACT0, (const char*)VT, (int)blockIdx.x}; EpiBf16 E{ACT1, D, nullptr, 1.f};
        pg8::gemm_phase<EpiBf16, AttnSched<1>, false, false, SLOW>(F.lds, D, MEML, 256, S, E); }
    SEAM(7);
    PH(8) { REPBAR(); DenseSched S; S.init(ACT1, Wo_t, D, D, T, D, F.G, (int)blockIdx.x); EpiRes E{X1, X1, ACT0, ssq2};
        pg8::gemm_phase<EpiRes, DenseSched, false, false, SLOW>(F.lds, D, D, D, S, E); }
    SEAM(8);
    PH(9) { REPBAR();
        LAS float* WRl = (LAS float*)F.lds;
        const int item = F.wave & 3, ks = F.wave >> 2, t0 = F.vcu * 64 + item * 16, row = F.lane & 15, q = F.lane >> 4;
        f32x4 acc0 = {0.f, 0.f, 0.f, 0.f}, acc1 = acc0, acc2 = acc0;
        const float* xr = X1 + (size_t)(t0 + row) * D + 4 * q + ks * 256;
#pragma unroll 1
        for (int h = 0; h < 2; ++h) {
            __syncthreads();
#pragma unroll
            for (int i = 0; i < 12; ++i) { const int idx4 = F.tid + 512 * i, k = idx4 / 12, j4 = idx4 % 12; *(LAS f32x4*)(WRl + k * 52 + j4 * 4) = *(const f32x4*)(WR + (size_t)(h * 512 + k) * 48 + j4 * 4); }
            f32x4 a[16];
#pragma unroll
            for (int jj = 0; jj < 16; ++jj) a[jj] = *(const f32x4*)(xr + h * 512 + 16 * jj);
            LDS_WAIT(); __syncthreads();
#pragma unroll
            for (int jj = 0; jj < 16; ++jj)
#pragma unroll
                for (int i = 0; i < 4; ++i) { const LAS float* wp = WRl + (ks * 256 + 16 * jj + 4 * q + i) * 52 + row;
                    acc0 = __builtin_amdgcn_mfma_f32_16x16x4f32(a[jj][i], wp[0], acc0, 0, 0, 0); acc1 = __builtin_amdgcn_mfma_f32_16x16x4f32(a[jj][i], wp[16], acc1, 0, 0, 0); acc2 = __builtin_amdgcn_mfma_f32_16x16x4f32(a[jj][i], wp[32], acc2, 0, 0, 0); }
        }
        __syncthreads();
        LAS f32x4* CB = (LAS f32x4*)F.lds;
        LAS float* sl = (LAS float*)(F.lds + 16384) + item * 832;
        LAS int* LC = (LAS int*)(F.lds + 32768); LAS int* GB = LC + 32;
        if (ks == 1) { CB[(item * 3 + 0) * 64 + F.lane] = acc0; CB[(item * 3 + 1) * 64 + F.lane] = acc1; CB[(item * 3 + 2) * 64 + F.lane] = acc2; }
        if (F.tid < 32) LC[F.tid] = 0;
        LDS_WAIT(); __syncthreads();
        int e0 = 0, e1 = 0, lr0 = 0, lr1 = 0; const bool decider = (ks == 0) && (F.lane < 16); const int t = t0 + F.lane;
        if (ks == 0) {
            acc0 = acc0 + CB[(item * 3 + 0) * 64 + F.lane]; acc1 = acc1 + CB[(item * 3 + 1) * 64 + F.lane]; acc2 = acc2 + CB[(item * 3 + 2) * 64 + F.lane];
#pragma unroll
            for (int r = 0; r < 4; ++r) { sl[(4 * q + r) * 52 + row] = acc0[r]; sl[(4 * q + r) * 52 + 16 + row] = acc1[r]; sl[(4 * q + r) * 52 + 32 + row] = acc2[r]; }
            LDS_WAIT(); __builtin_amdgcn_wave_barrier();
            if (F.lane < 16) { LAS float* L = sl + F.lane * 52;
                const float rs = rsqrtf(((ssq2[t] + ssq2[T + t]) + (ssq2[2 * T + t] + ssq2[3 * T + t])) * (1.f / D) + EPS);
                float gm = -1e30f; int gi = 0;
                for (int j = 0; j < 4; ++j) { const float v = L[j] * rs + p_b_rg[j]; if (v > gm) { gm = v; gi = j; } }
                float gs = 0.f; for (int j = 0; j < 4; ++j) gs += __expf(L[j] * rs + p_b_rg[j] - gm);
                const float gwt = 1.f / gs;
                float em = -1e30f;
                for (int j = 0; j < 8; ++j) { const float v = L[4 + gi * 8 + j] * rs + p_b_re[gi * 8 + j]; L[40 + j] = v; em = fmaxf(em, v); }
                float es = 0.f; for (int j = 0; j < 8; ++j) { const float p = __expf(L[40 + j] - em); L[40 + j] = p; es += p; }
                int i0 = 0; float p0 = L[40];
                for (int j = 1; j < 8; ++j) { const float p = L[40 + j]; if (p > p0) { p0 = p; i0 = j; } }
                int i1 = -1; float p1 = -1.f;
                for (int j = 0; j < 8; ++j) { const float p = L[40 + j]; if (j != i0 && p > p1) { p1 = p; i1 = j; } }
                p0 /= es; p1 /= es; const float ssum = p0 + p1; e0 = gi * 8 + i0; e1 = gi * 8 + i1;
                rstd2[t] = rs; tokg[t * 2] = gwt * p0 / ssum; tokg[t * 2 + 1] = gwt * p1 / ssum;
                lr0 = __hip_atomic_fetch_add(&LC[e0], 1, __ATOMIC_RELAXED, __HIP_MEMORY_SCOPE_WORKGROUP); lr1 = __hip_atomic_fetch_add(&LC[e1], 1, __ATOMIC_RELAXED, __HIP_MEMORY_SCOPE_WORKGROUP); }
        }
        LDS_WAIT(); __syncthreads();
        if (F.tid < 32) { const int c = LC[F.tid]; GB[F.tid] = c ? atomicAdd(&CNT[F.tid * 64], c) : 0; }
        LDS_WAIT(); __syncthreads();
        if (decider) { LIST[e0 * T + GB[e0] + lr0] = t * 2; LIST[e1 * T + GB[e1] + lr1] = t * 2 + 1; }
        LDS_WAIT(); __syncthreads();
    }
    SEAM(9);
    LAS int* tp = (LAS int*)(F.lds + MOE_TP_OFF); LAS int* lcnt = tp + 40; LAS int* lbase = tp + 80;
    if (IN(10) || IN(11)) {
        if (F.tid == 0) { int a = 0, bsum = 0; for (int e = 0; e < NEXP; ++e) { const int c = __hip_atomic_load((const int*)&CNT[e * 64], RLX_AGENT); tp[e] = a; lcnt[e] = c; lbase[e] = bsum; a += (c + 255) >> 8; bsum += c; } tp[NEXP] = a; lbase[NEXP] = bsum; }
        LDS_WAIT(); __syncthreads();
    }
    PH(10) { REPBAR(); MoeSched<0> S{(const char*)ACT0, (const char*)WGU, LIST, tp, lcnt, lbase, F.G, (int)blockIdx.x}; EpiGU E{LIST, lcnt, rstd2, ACT1};
        pg8::gemm_phase<EpiGU, MoeSched<0>, true, true, SLOW>(F.lds, D, D, D, S, E); }
    SEAM(10);
    PH(11) { REPBAR(); MoeSched<1> S{(const char*)ACT1, (const char*)WD, LIST, tp, lcnt, lbase, F.G, (int)blockIdx.x}; EpiDown E{LIST, lcnt, tokg, ACT0, Y1};
        pg8::gemm_phase<EpiDown, MoeSched<1>, true, false, SLOW>(F.lds, DEXP, DEXP, DEXP, S, E); }
    SEAM(11);
    PH(12) { REPBAR();
        for (int t = gw; t < T; t += NGW) { f32x4 v[4]; float s = 0.f;
#pragma unroll
            for (int j = 0; j < 4; ++j) { const size_t o = (size_t)t * D + 4 * F.lane + 256 * j; v[j] = *(const f32x4*)(X1 + o);
                const u32x2 a = *(const u32x2*)(ACT0 + o), b = *(const u32x2*)(Y1 + o);
                v[j][0] += __uint_as_float(a.x << 16) + __uint_as_float(b.x << 16); v[j][1] += __uint_as_float(a.x & 0xffff0000u) + __uint_as_float(b.x & 0xffff0000u);
                v[j][2] += __uint_as_float(a.y << 16) + __uint_as_float(b.y << 16); v[j][3] += __uint_as_float(a.y & 0xffff0000u) + __uint_as_float(b.y & 0xffff0000u);
                s += (v[j][0] * v[j][0] + v[j][1] * v[j][1]) + (v[j][2] * v[j][2] + v[j][3] * v[j][3]); }
            const float r = rsqrtf(wave_sum(s) * (1.f / D) + EPS);
#pragma unroll
            for (int j = 0; j < 4; ++j) { const int c = 4 * F.lane + 256 * j; const f32x4 g = *(const f32x4*)(p_final_g + c); *(f32x4*)(args.out + (size_t)t * D + c) = v[j] * r * g; } }
    }
#undef IN
#undef SEAM
}

constexpr int NPHASE = 13;
extern "C" void kernel_launch(void* const* d_in, const int* in_sizes, int n_in, void* d_out, int out_size, void* d_ws, size_t ws_size, hipStream_t stream) {
    static int grid = 0;
    if (grid == 0) {
        if (n_in != 22 || out_size != T * D || ws_size < WS_END) { fprintf(stderr, "kernel_launch: unexpected problem (n_in %d out %d ws %zu)\n", n_in, out_size, ws_size); grid = -1; return; }
        int dev = 0, cus = 0, per_cu = 0;
        if (hipGetDevice(&dev) != hipSuccess || hipDeviceGetAttribute(&cus, hipDeviceAttributeMultiprocessorCount, dev) != hipSuccess) { grid = -1; return; }
        if (hipFuncSetAttribute((const void*)mk_fwd, hipFuncAttributeMaxDynamicSharedMemorySize, LDS_BYTES) != hipSuccess) { fprintf(stderr, "kernel_launch: hipFuncSetAttribute failed\n"); grid = -1; return; }
        if (hipOccupancyMaxActiveBlocksPerMultiprocessor(&per_cu, (const void*)mk_fwd, NWAVES * 64, LDS_BYTES) != hipSuccess || per_cu < 1) { fprintf(stderr, "kernel_launch: occupancy query says %d\n", per_cu); per_cu = 1; }
        (void)hipGetLastError();
        grid = cus;
        if (grid != 256) fprintf(stderr, "kernel_launch: %d CUs (built for 256)\n", grid);
    }
    if (grid < 0) return;
    (void)hipMemsetAsync((char*)d_ws + WS_CTL, 0, CTL_ZERO_BYTES, stream);
    Args a{};
    for (int i = 0; i < 22; ++i) a.in[i] = (const float*)d_in[i];
    a.out = (float*)d_out; a.ws = (unsigned char*)d_ws; a.ph_lo = 0; a.ph_hi = NPHASE;
    hipLaunchKernelGGL(mk_fwd, dim3(grid), dim3(NWAVES * 64), LDS_BYTES, stream, a);
#if MK_PROBE_PHASE >= 0
    (void)hipMemsetAsync((char*)d_ws + WS_CTL, 0, 65536, stream);
    a.ph_lo = MK_PROBE_PHASE; a.ph_hi = MK_PROBE_PHASE + 1;
    hipLaunchKernelGGL(mk_fwd, dim3(grid), dim3(NWAVES * 64), LDS_BYTES, stream, a);
#endif
}
```
